# Optimizing an MI355X kernel written in HIP

```python
import math
import jax
import jax.numpy as jnp
from jax import lax
import numpy as np

D_MODEL = 2048
BATCH = 1
SEQ = 8192
DEPTH = 2
DEC_BATCH = 32
DEC_SEQ = 4
PAST_LEN = 8192
PAGE_SIZE = 128

N_EVEN = (DEPTH + 1) // 2
N_ODD = DEPTH // 2
RET_HEADS = 8
RET_DK = 128
RET_DV = 256
RET_CHUNK = 128
RET_THETA = 10000.0
SWA_HEADS = 8
SWA_HD = 128
SWA_PATTERNS = ((128, 1), (512, 4), (2048, 16))
SWA_MAX_WINDOW = 2048
SWA_BLOCK = 128
ROPE_THETA = 500000.0
ROPE_DIMS = SWA_HD // 4
GMLP_CHUNK = 128
GMLP_WIDTH = D_MODEL
GMLP_GROUP = 128
GMLP_GROUPS = GMLP_WIDTH // GMLP_GROUP
MEM_LEN = 256
MEM_HEADS = 4
MEM_HD = 128
NORM_EPS = 1e-6
NEG_INF = -1e30
EVEN_IN_WIDTHS = (RET_HEADS * RET_DK, RET_HEADS * RET_DK, RET_HEADS * RET_DV, RET_HEADS * RET_DV,
                  SWA_HEADS * SWA_HD, SWA_HEADS * SWA_HD, SWA_HEADS * SWA_HD, SWA_HEADS * SWA_HD,
                  MEM_HEADS * MEM_HD, MEM_HEADS * MEM_HD)
ODD_IN_WIDTHS = (2 * GMLP_WIDTH, GMLP_WIDTH, MEM_HEADS * MEM_HD, MEM_HEADS * MEM_HD)
EVEN_IN = sum(EVEN_IN_WIDTHS)
EVEN_OUT = RET_HEADS * RET_DV + SWA_HEADS * SWA_HD + MEM_HEADS * MEM_HD
ODD_IN = sum(ODD_IN_WIDTHS)
ODD_OUT = GMLP_WIDTH + MEM_HEADS * MEM_HD

kernel_name = 'hybrid_retnet_dilated_gmlp_decoder_step'

F32 = jnp.float32


def split_cols(a, widths):
    out, start = [], 0
    for w in widths:
        out.append(a[..., start:start + w])
        start += w
    return out


def rms_norm(x, g):
    xf = x.astype(F32)
    y = xf * lax.rsqrt(jnp.mean(xf * xf, axis=-1, keepdims=True) + NORM_EPS)
    return (y * g.astype(F32)).astype(x.dtype)


def layer_norm(x, g):
    xf = x.astype(F32)
    mu = jnp.mean(xf, axis=-1, keepdims=True)
    var = jnp.mean(jnp.square(xf - mu), axis=-1, keepdims=True)
    return ((xf - mu) * lax.rsqrt(var + NORM_EPS) * g.astype(F32)).astype(x.dtype)


def rotary(x, pos, n_rot, theta):
    half = n_rot // 2
    inv = 1.0 / (theta ** (jnp.arange(half, dtype=F32) / half))
    ang = pos.astype(F32)[:, None] * inv[None, :]
    cos = jnp.cos(ang)[:, None, :]
    sin = jnp.sin(ang)[:, None, :]
    xf = x.astype(F32)
    x1, x2 = xf[..., :half], xf[..., half:n_rot]
    out = jnp.concatenate([x1 * cos - x2 * sin, x2 * cos + x1 * sin, xf[..., n_rot:]], axis=-1)
    return out.astype(x.dtype)


def retention_chunk(state, q, k, v, log_gamma):
    c = q.shape[1]
    idx = jnp.arange(c, dtype=F32)
    rel = idx[:, None] - idx[None, :]
    decay = jnp.where(rel >= 0, jnp.exp(log_gamma[:, None, None] * jnp.maximum(rel, 0.0)), 0.0)
    qf, kf, vf = q.astype(F32), k.astype(F32), v.astype(F32)
    scores = jnp.einsum('bihd,bjhd->bhij', qf, kf) * decay[None]
    inner = jnp.einsum('bhij,bjhe->bihe', scores, vf)
    q_decay = jnp.exp(log_gamma[:, None] * (idx[None, :] + 1.0))
    cross = jnp.einsum('bihd,hi,bhde->bihe', qf, q_decay, state)
    k_decay = jnp.exp(log_gamma[:, None] * (c - 1.0 - idx[None, :]))
    chunk_decay = jnp.exp(log_gamma * c)
    new_state = chunk_decay[None, :, None, None] * state + jnp.einsum('bjhd,hj,bjhe->bhde', kf, k_decay, vf)
    return new_state, inner + cross


def retention(state0, q, k, v):
    b, t, h, _ = q.shape
    c = math.gcd(t, RET_CHUNK)
    nc = t // c
    log_gamma = jnp.log1p(-jnp.exp2(-5.0 - jnp.arange(RET_HEADS, dtype=F32)))

    def chunks(a):
        return a.reshape(b, nc, c, h, a.shape[-1]).swapaxes(0, 1)

    def step(s, qkv):
        q_c, k_c, v_c = qkv
        return retention_chunk(s, q_c, k_c, v_c, log_gamma)

    state, out = lax.scan(step, state0.astype(F32), (chunks(q), chunks(k), chunks(v)))
    return state, out.swapaxes(0, 1).reshape(b, t, h, RET_DV)


def head_group_norm(o, g):
    mu = jnp.mean(o, axis=-1, keepdims=True)
    var = jnp.mean(jnp.square(o - mu), axis=-1, keepdims=True)
    y = (o - mu) * lax.rsqrt(var + NORM_EPS)
    return y.reshape(o.shape[0], o.shape[1], -1) * g.astype(F32)


def dilated_prompt(q, k, v, window, dilation):
    b, t, h, d = q.shape
    span = window // dilation
    blk = SWA_BLOCK
    unit = dilation * blk
    t_pad = -(-t // unit) * unit
    L = t_pad // dilation
    nb = L // blk

    def strided(a):
        a = jnp.pad(a, ((0, 0), (0, t_pad - t), (0, 0), (0, 0)))
        a = a.reshape(b, L, dilation, h, d).transpose(0, 2, 1, 3, 4)
        return a.reshape(b, dilation, nb, blk, h, d).astype(F32)

    qs, ks, vs = strided(q), strided(k), strided(v)

    def with_prev(a):
        prev = jnp.pad(a[:, :, :-1], ((0, 0), (0, 0), (1, 0), (0, 0), (0, 0), (0, 0)))
        return jnp.concatenate([prev, a], axis=3)

    kw, vw = with_prev(ks), with_prev(vs)
    s = jnp.einsum('brnihd,brnjhd->brnihj', qs, kw)
    qi = jnp.arange(blk)[:, None] + blk
    kj = jnp.arange(2 * blk)[None, :]
    dist = qi - kj
    key_pos = jnp.arange(nb)[:, None, None] * blk + kj[None] - blk
    valid = ((dist >= 0) & (dist <= span))[None] & (key_pos >= 0)
    valid = valid[:, :, None, :]
    s = jnp.where(valid, s, NEG_INF)
    m = jnp.max(s, axis=-1)
    p = jnp.where(valid, jnp.exp(s - m[..., None]), 0.0)
    l = jnp.sum(p, axis=-1)
    acc = jnp.einsum('brnihj,brnjhd->brnihd', p, vw)

    def unstride(a):
        a = a.reshape((b, dilation, L) + a.shape[4:])
        a = jnp.moveaxis(a, 1, 2).reshape((b, t_pad) + a.shape[3:])
        return a[:, :t]

    return unstride(m), unstride(l), unstride(acc)


def dilated_sample(q, k_all, v_all, window, dilation, buf_len):
    t = q.shape[1]
    steps = jnp.arange(window // dilation + 1)
    idx = buf_len + jnp.arange(t)[:, None] - steps[None, :] * dilation
    valid = (idx >= 0)[None, :, None, :]
    idx_c = jnp.maximum(idx, 0)
    kg = k_all[:, idx_c].astype(F32)
    vg = v_all[:, idx_c].astype(F32)
    s = jnp.einsum('bthd,btkhd->bthk', q.astype(F32), kg)
    s = jnp.where(valid, s, NEG_INF)
    m = jnp.max(s, axis=-1)
    p = jnp.where(valid, jnp.exp(s - m[..., None]), 0.0)
    l = jnp.sum(p, axis=-1)
    acc = jnp.einsum('bthk,btkhd->bthd', p, vg)
    return m, l, acc


def combine_dilations(parts):
    ms = jnp.stack([p[0] for p in parts])
    mmax = jnp.max(ms, axis=0)
    wts = jnp.exp(ms - mmax[None])
    num = sum(wts[i][..., None] * parts[i][2] for i in range(len(parts)))
    den = sum(wts[i] * parts[i][1] for i in range(len(parts)))
    return num / den[..., None]


def memory_attend(q, mem_k, mem_v):
    b, t, _ = q.shape
    qh = q.reshape(b, t, MEM_HEADS, MEM_HD).astype(F32) * (MEM_HD ** -0.5)
    s = jnp.einsum('bthd,bmhd->bthm', qh, mem_k.astype(F32))
    p = jax.nn.softmax(s, axis=-1)
    o = jnp.einsum('bthm,bmhd->bthd', p, mem_v.astype(F32))
    return o.reshape(b, t, -1).astype(q.dtype)


def even_mix(xn, pos, ret_state0, swa_past, mem_k, mem_v, w_in, ret_gn, w_out):
    b, t, _ = xn.shape
    proj = xn @ w_in
    aq, ak, av, ag, bq, bk, bv, bg, mq, mg = split_cols(proj, EVEN_IN_WIDTHS)
    aq = rotary(aq.reshape(b, t, RET_HEADS, RET_DK), pos, RET_DK, RET_THETA)
    ak = rotary(ak.reshape(b, t, RET_HEADS, RET_DK), pos, RET_DK, RET_THETA) * (RET_DK ** -0.5)
    av = av.reshape(b, t, RET_HEADS, RET_DV)
    ret_state, ao = retention(ret_state0, aq, ak, av)
    ya = head_group_norm(ao, ret_gn).astype(xn.dtype) * jax.nn.silu(ag)
    bq = rotary(bq.reshape(b, t, SWA_HEADS, SWA_HD), pos, ROPE_DIMS, ROPE_THETA) * (SWA_HD ** -0.5)
    bk = rotary(bk.reshape(b, t, SWA_HEADS, SWA_HD), pos, ROPE_DIMS, ROPE_THETA)
    bv = bv.reshape(b, t, SWA_HEADS, SWA_HD)
    if swa_past is None:
        parts = [dilated_prompt(bq, bk, bv, w, r) for (w, r) in SWA_PATTERNS]
        buf = min(SWA_MAX_WINDOW, t)
        new_k, new_v = bk[:, t - buf:], bv[:, t - buf:]
    else:
        past_k, past_v = swa_past
        k_all = jnp.concatenate([past_k.astype(bk.dtype), bk], axis=1)
        v_all = jnp.concatenate([past_v.astype(bv.dtype), bv], axis=1)
        parts = [dilated_sample(bq, k_all, v_all, w, r, past_k.shape[1]) for (w, r) in SWA_PATTERNS]
        new_k, new_v = bk, bv
    yb = combine_dilations(parts).reshape(b, t, -1).astype(xn.dtype) * jax.nn.silu(bg)
    ym = memory_attend(mq, mem_k, mem_v) * jax.nn.silu(mg)
    out = jnp.concatenate([ya, yb, ym], axis=-1) @ w_out
    return out, ret_state, new_k, new_v


def spatial_gating(u, v, w_s, b_s):
    b, t, w = v.shape
    c = GMLP_CHUNK
    t_pad = -(-t // c) * c
    nc = t_pad // c
    vp = jnp.pad(v, ((0, 0), (0, t_pad - t), (0, 0))).reshape(b, nc, c, GMLP_GROUPS, GMLP_GROUP)
    w_causal = w_s * jnp.tril(jnp.ones((c, c), w_s.dtype))[None]
    mixed = jnp.einsum('gts,bcsgk->bctgk', w_causal, vp) + b_s.T[None, None, :, :, None]
    mixed = mixed.reshape(b, t_pad, w)[:, :t]
    return u * mixed


def odd_mix(xn, mem_k, mem_v, w_in, gmlp_ln, w_s, b_s, w_out):
    t = xn.shape[1]
    proj = xn @ w_in
    uv, z, mq, mg = split_cols(proj, ODD_IN_WIDTHS)
    uv = jax.nn.gelu(uv)
    u, v = uv[..., :GMLP_WIDTH], uv[..., GMLP_WIDTH:]
    v = layer_norm(v, gmlp_ln)
    yc = spatial_gating(u, v, w_s, b_s) * jax.nn.silu(z)
    ym = memory_attend(mq, mem_k, mem_v) * jax.nn.silu(mg)
    out = jnp.concatenate([yc, ym], axis=-1) @ w_out
    last_start = ((t - 1) // GMLP_CHUNK) * GMLP_CHUNK
    return out, v[:, last_start:]


def setup_inputs(seed: int = 0) -> dict:
    key = jax.random.key(seed)
    ks = jax.random.split(key, 24)
    buf = min(SWA_MAX_WINDOW, PAST_LEN)

    def nrm(k, shape, scale=1.0):
        return jax.random.normal(k, shape, F32) * scale

    def gain(k, shape):
        return 1.0 + 0.05 * jax.random.normal(k, shape, F32)

    return {
        'x_prompt': nrm(ks[0], (BATCH, SEQ, D_MODEL)),
        'x_sample': nrm(ks[1], (DEC_BATCH, DEC_SEQ, D_MODEL)),
        'state_ret': nrm(ks[2], (N_EVEN, DEC_BATCH, RET_HEADS, RET_DK, RET_DV)),
        'cache_swa_k': nrm(ks[3], (N_EVEN, DEC_BATCH, buf, SWA_HEADS, SWA_HD)),
        'cache_swa_v': nrm(ks[4], (N_EVEN, DEC_BATCH, buf, SWA_HEADS, SWA_HD)),
        'cache_mem_k': nrm(ks[5], (DEPTH, DEC_BATCH, MEM_LEN, MEM_HEADS, MEM_HD)),
        'cache_mem_v': nrm(ks[6], (DEPTH, DEC_BATCH, MEM_LEN, MEM_HEADS, MEM_HD)),
        'mem_prompt': nrm(ks[7], (BATCH, MEM_LEN, D_MODEL)),
        'pre_norm': gain(ks[8], (DEPTH, D_MODEL)),
        'post_norm': gain(ks[9], (DEPTH, D_MODEL)),
        'mem_norm': gain(ks[10], (DEPTH, D_MODEL)),
        'w_mem_k': nrm(ks[11], (DEPTH, D_MODEL, MEM_HEADS * MEM_HD), D_MODEL ** -0.5),
        'w_mem_v': nrm(ks[12], (DEPTH, D_MODEL, MEM_HEADS * MEM_HD), D_MODEL ** -0.5),
        'w_in_even': nrm(ks[13], (N_EVEN, D_MODEL, EVEN_IN), D_MODEL ** -0.5),
        'ret_gn': gain(ks[14], (N_EVEN, RET_HEADS * RET_DV)),
        'w_out_even': nrm(ks[15], (N_EVEN, EVEN_OUT, D_MODEL), EVEN_OUT ** -0.5),
        'w_in_odd': nrm(ks[16], (N_ODD, D_MODEL, ODD_IN), D_MODEL ** -0.5),
        'gmlp_ln': gain(ks[17], (N_ODD, GMLP_WIDTH)),
        'w_spatial': nrm(ks[18], (N_ODD, GMLP_GROUPS, GMLP_CHUNK, GMLP_CHUNK), GMLP_CHUNK ** -0.5),
        'b_spatial': 1.0 + 0.1 * jax.random.normal(ks[19], (N_ODD, GMLP_GROUPS, GMLP_CHUNK), F32),
        'w_out_odd': nrm(ks[20], (N_ODD, ODD_OUT, D_MODEL), ODD_OUT ** -0.5),
    }


def reference(x_prompt, x_sample, state_ret, cache_swa_k, cache_swa_v, cache_mem_k, cache_mem_v, mem_prompt,
              pre_norm, post_norm, mem_norm, w_mem_k, w_mem_v, w_in_even, ret_gn, w_out_even,
              w_in_odd, gmlp_ln, w_spatial, b_spatial, w_out_odd):
    bp, tp, _ = x_prompt.shape
    pos_p = jnp.arange(tp, dtype=jnp.int32)
    pos_s = PAST_LEN + jnp.arange(x_sample.shape[1], dtype=jnp.int32)
    hp, hs = x_prompt, x_sample
    p_ret, p_k, p_v, p_mk, p_mv, p_gv = [], [], [], [], [], []
    s_ret, s_k, s_v, s_gv = [], [], [], []
    for layer in range(DEPTH):
        e = layer // 2
        memn = rms_norm(mem_prompt, mem_norm[layer])
        mk_p = (memn @ w_mem_k[layer]).reshape(bp, MEM_LEN, MEM_HEADS, MEM_HD)
        mv_p = (memn @ w_mem_v[layer]).reshape(bp, MEM_LEN, MEM_HEADS, MEM_HD)
        p_mk.append(mk_p)
        p_mv.append(mv_p)
        xn_p = rms_norm(hp, pre_norm[layer])
        xn_s = rms_norm(hs, pre_norm[layer])
        if layer % 2 == 0:
            zero_state = jnp.zeros((bp, RET_HEADS, RET_DK, RET_DV), F32)
            op, st_p, kp, vp = even_mix(xn_p, pos_p, zero_state, None, mk_p, mv_p,
                                        w_in_even[e], ret_gn[e], w_out_even[e])
            osm, st_s, ksm, vsm = even_mix(xn_s, pos_s, state_ret[e], (cache_swa_k[e], cache_swa_v[e]),
                                           cache_mem_k[layer], cache_mem_v[layer],
                                           w_in_even[e], ret_gn[e], w_out_even[e])
            p_ret.append(st_p)
            p_k.append(kp)
            p_v.append(vp)
            s_ret.append(st_s)
            s_k.append(ksm)
            s_v.append(vsm)
        else:
            op, gv_p = odd_mix(xn_p, mk_p, mv_p, w_in_odd[e], gmlp_ln[e], w_spatial[e], b_spatial[e], w_out_odd[e])
            osm, gv_s = odd_mix(xn_s, cache_mem_k[layer], cache_mem_v[layer], w_in_odd[e], gmlp_ln[e],
                                w_spatial[e], b_spatial[e], w_out_odd[e])
            p_gv.append(gv_p)
            s_gv.append(gv_s)
        hp = hp + rms_norm(op, post_norm[layer])
        hs = hs + rms_norm(osm, post_norm[layer])
    return (hp, hs,
            jnp.stack(p_ret), jnp.stack(p_k), jnp.stack(p_v), jnp.stack(p_mk), jnp.stack(p_mv), jnp.stack(p_gv),
            jnp.stack(s_ret), jnp.stack(s_k), jnp.stack(s_v), jnp.stack(s_gv))
```

```cpp
#include <hip/hip_runtime.h>
#include <hip/hip_cooperative_groups.h>
#include <cstdio>
namespace cg = cooperative_groups;

#define DI __device__ __forceinline__
#define LAS __attribute__((address_space(3)))
typedef unsigned short bf16_t;
typedef unsigned char uchar;
typedef short bf16x8 __attribute__((ext_vector_type(8)));
typedef short s16x4 __attribute__((ext_vector_type(4)));
typedef float f32x4 __attribute__((ext_vector_type(4)));
typedef float f32x2 __attribute__((ext_vector_type(2)));
typedef float f32x16 __attribute__((ext_vector_type(16)));
typedef unsigned u32x2 __attribute__((ext_vector_type(2)));
typedef unsigned u32x4 __attribute__((ext_vector_type(4)));
typedef __bf16 bfv2 __attribute__((ext_vector_type(2)));

#define MFMA32(a, b, c) __builtin_amdgcn_mfma_f32_32x32x16_bf16((a), (b), (c), 0, 0, 0)

constexpr int TP = 8192;
constexpr int NROW = 8320;
constexpr int MPAD = 8448;
constexpr int LD0 = 11264, LD1 = 7168, LDC0 = 3584, LDC1 = 2560;
constexpr float RSQ128 = 0.08838834764831845f;
constexpr int LDS_BYTES = 139264;
constexpr int XCD_BAR_WORDS_C = 3456;
constexpr int LDS_BAR_OFF = LDS_BYTES - 16;

constexpr size_t O_Y = 0, O_PSTATE = 17039360, O_PSWAK = 17301504, O_PSWAV = 19398656, O_PMEMK = 21495808,
                 O_PMEMV = 21757952, O_PGV = 22020096, O_SSTATE = 22282240, O_SSWAK = 30670848, O_SSWAV = 30801920, O_SGV = 30932992;

constexpr size_t al256(size_t x) { return (x + 255) & ~(size_t)255; }
constexpr size_t W_A0 = 0;
constexpr size_t W_WT1 = al256(W_A0 + (size_t)8960 * 2048 * 2);
constexpr size_t W_WT2 = al256(W_WT1 + (size_t)13312 * 2048 * 2);
constexpr size_t W_WT3 = al256(W_WT2 + (size_t)2048 * 3584 * 2);
constexpr size_t W_WT4 = al256(W_WT3 + (size_t)7168 * 2048 * 2);
constexpr size_t W_P0 = al256(W_WT4 + (size_t)2048 * 2560 * 2);
constexpr size_t W_MEMKV = al256(W_P0 + (size_t)MPAD * LD0 * 2);
constexpr size_t W_KVT = al256(W_MEMKV + (size_t)2 * 256 * 1024 * 2);
constexpr size_t W_STB = al256(W_KVT + (size_t)512 * 256 * 128 * 4);
constexpr size_t W_DILO = al256(W_STB + (size_t)512 * 256 * 128 * 2);
constexpr size_t W_DILM = al256(W_DILO + (size_t)3 * 8192 * 1024 * 2);
constexpr size_t W_DILL = al256(W_DILM + (size_t)3 * 8192 * 8 * 4);
constexpr size_t W_CAT0 = al256(W_DILL + (size_t)3 * 8192 * 8 * 4);
constexpr size_t W_O = al256(W_CAT0 + (size_t)MPAD * LDC0 * 2);
constexpr size_t W_XN1 = al256(W_O + (size_t)MPAD * 2048 * 4);
constexpr size_t W_P1 = al256(W_XN1 + (size_t)MPAD * 2048 * 2);
constexpr size_t W_LNS = al256(W_P1 + (size_t)MPAD * LD1 * 2);
constexpr size_t W_CAT1 = al256(W_LNS + (size_t)MPAD * 2 * 4);
constexpr size_t W_TAC = al256(W_CAT1 + (size_t)MPAD * LDC1 * 2);
constexpr size_t W_TAS = al256(W_TAC + (size_t)MPAD * 64 * 4);
constexpr size_t W_TBC = al256(W_TAS + (size_t)MPAD * 64 * 4);
constexpr size_t W_TBS = al256(W_TBC + (size_t)MPAD * 16 * 4);
constexpr size_t W_WC = al256(W_TBS + (size_t)MPAD * 16 * 4);
constexpr size_t W_KFD = al256(W_WC + (size_t)16 * 128 * 128 * 2);
constexpr size_t W_KFR = al256(W_KFD + (size_t)3 * 8192 * 1024 * 2);
constexpr size_t W_KFM = al256(W_KFR + (size_t)8192 * 1024 * 2);
constexpr size_t W_BAR = al256(W_KFM + (size_t)2 * 256 * 512 * 2);
constexpr size_t W_END = al256(W_BAR + (size_t)XCD_BAR_WORDS_C * 4);

struct Params {
    const float *x_prompt, *x_sample, *state_ret, *cache_k, *cache_v, *cmem_k, *cmem_v, *mem_prompt, *pre_norm, *post_norm, *mem_norm,
        *w_mem_k, *w_mem_v, *w_in_even, *ret_gn, *w_out_even, *w_in_odd, *gmlp_ln, *w_spatial, *b_spatial, *w_out_odd;
    float* out;
    uchar* ws;
};

DI int otid() { int t = __builtin_amdgcn_workitem_id_x(); asm volatile("" : "+v"(t)); return t; }
DI unsigned pk_bf16(float lo, float hi) { f32x2 v = {lo, hi}; bfv2 b = __builtin_convertvector(v, bfv2); return __builtin_bit_cast(unsigned, b); }
DI bf16_t f2bf(float x) { return (bf16_t)(pk_bf16(x, 0.f) & 0xffffu); }
DI float bf_lo(unsigned u) { return __uint_as_float(u << 16); }
DI float bf_hi(unsigned u) { return __uint_as_float(u & 0xffff0000u); }
DI float bf2f(bf16_t b) { return __uint_as_float(((unsigned)b) << 16); }
DI float wave_sum(float v) { for (int o = 32; o > 0; o >>= 1) v += __shfl_xor(v, o); return v; }
DI float wave_max(float v) { for (int o = 32; o > 0; o >>= 1) v = fmaxf(v, __shfl_xor(v, o)); return v; }
DI float silu_f(float x) { return x * __builtin_amdgcn_rcpf(1.f + __expf(-x)); }
DI float gelu_f(float x) { const float u = 0.7978845608028654f * (x + 0.044715f * x * x * x); return x * __builtin_amdgcn_rcpf(1.f + __expf(-2.f * u)); }
DI int crow(int i, int h) { return (i & 3) + 8 * (i >> 2) + 4 * h; }
DI bf16x8 pack8(float a, float b, float c, float d, float e, float f, float g, float h) {
    u32x4 p = {pk_bf16(a, b), pk_bf16(c, d), pk_bf16(e, f), pk_bf16(g, h)}; return __builtin_bit_cast(bf16x8, p); }
DI s16x4 trr(LAS uchar* a) { return __builtin_amdgcn_ds_read_tr16_b64_v4i16((LAS s16x4*)a); }
DI bf16x8 tr_frag(LAS uchar* base, int RS, int krow_lo, int krow_hi, int col0, int lane) {
    const int i16 = lane & 15, q = i16 >> 2, pq = i16 & 3, blk = (lane >> 4) & 1;
    const int cb = (col0 + 16 * blk) * 2 + 8 * pq;
    s16x4 lo = trr(base + (krow_lo + q) * RS + cb);
    s16x4 hi = trr(base + (krow_hi + q) * RS + cb);
    return __builtin_shufflevector(lo, hi, 0, 1, 2, 3, 4, 5, 6, 7);
}

#define XB_TMO      128
#define XB_XCNT(j)  (256  + 64 * (j))
#define XB_XSUB(j)  (1280 + 64 * (j))
#define XB_XGEN(j)  (2304 + 64 * (j))
#define XB_TOP      3328
#define XB_TOPGEN   3392
#define XCD_BAR_WORDS 3456
#define XB_SPIN_CAP (1u << 22)
DI unsigned xb_ld(unsigned* p) { return __hip_atomic_load(p, __ATOMIC_RELAXED, __HIP_MEMORY_SCOPE_AGENT); }
DI unsigned xb_add(unsigned* p, unsigned v) { return __hip_atomic_fetch_add(p, v, __ATOMIC_RELAXED, __HIP_MEMORY_SCOPE_AGENT); }
DI unsigned xb_xcc_id() { return (unsigned)__builtin_amdgcn_s_getreg((3 << 11) | 20) & 0xFu; }
#define XB_SPIN(cond, bar) do { unsigned _sp = 0; while (cond) { __builtin_amdgcn_s_sleep(1); \
    if ((++_sp & 255u) == 0u) { if (xb_ld(&(bar)[XB_TMO])) break; if (_sp > XB_SPIN_CAP) { atomicAdd(&(bar)[XB_TMO], 1u); break; } } } } while (0)
struct XcdBarrier { unsigned* bar; unsigned x; volatile LAS unsigned* st; };
DI XcdBarrier xcd_barrier_post(unsigned* bar, volatile LAS unsigned* st) {
    XcdBarrier b; b.bar = bar; b.x = xb_xcc_id(); b.st = st;
    if (otid() == 0) (void)xb_add(&bar[XB_XCNT(b.x)], 1u);
    return b;
}
DI void xcd_barrier_complete(unsigned* bar, unsigned x, unsigned& nloc, unsigned& nx) {
    const unsigned G = gridDim.x;
    unsigned sum, cnt, mine, sp = 0u;
    for (;;) {
        sum = 0u; cnt = 0u; mine = 0u;
#pragma unroll
        for (unsigned j = 0; j < 16; ++j) { const unsigned c = xb_ld(&bar[XB_XCNT(j)]); sum += c; cnt += (c > 0u) ? 1u : 0u; mine = (j == x) ? c : mine; }
        if (sum == G) break;
        __builtin_amdgcn_s_sleep(1);
        if ((++sp & 255u) == 0u) { if (xb_ld(&bar[XB_TMO])) break; if (sp > XB_SPIN_CAP) { atomicAdd(&bar[XB_TMO], 1u); break; } }
    }
    nloc = mine > 0u ? mine : 1u; nx = cnt > 0u ? cnt : 1u;
}
DI void xcd_barrier(const XcdBarrier& b) {
    asm volatile("s_waitcnt vmcnt(0)" ::: "memory");
    __syncthreads();
    if (otid() == 0) {
        unsigned* bar = b.bar;
        const unsigned bx = xb_xcc_id();
        __builtin_amdgcn_s_waitcnt(0);
        unsigned nloc = b.st[0], nx = b.st[1];
        if (nloc == 0u) { xcd_barrier_complete(bar, bx, nloc, nx); b.st[0] = nloc; b.st[1] = nx; }
        const unsigned old = xb_add(&bar[XB_XSUB(bx)], 1u);
        const unsigned gen = old / nloc;
        if (old + 1u == (gen + 1u) * nloc) {
            __builtin_amdgcn_fence(__ATOMIC_RELEASE, "agent");
            asm volatile("s_waitcnt vmcnt(0)" ::: "memory");
            const unsigned og = xb_add(&bar[XB_TOP], 1u);
            const unsigned tg = og / nx;
            if (og + 1u == (tg + 1u) * nx) xb_add(&bar[XB_TOPGEN], 1u);
            else XB_SPIN(xb_ld(&bar[XB_TOPGEN]) == tg, bar);
            __builtin_amdgcn_fence(__ATOMIC_ACQUIRE, "agent");
            xb_add(&bar[XB_XGEN(bx)], 1u);
            asm volatile("s_waitcnt vmcnt(0)" ::: "memory");
        } else {
            XB_SPIN(xb_ld(&bar[XB_XGEN(bx)]) == gen, bar);
            __builtin_amdgcn_fence(__ATOMIC_ACQUIRE, "agent");
            asm volatile("s_waitcnt vmcnt(0)" ::: "memory");
        }
    }
    __syncthreads();
}

namespace pg8 {
constexpr int BM = 256, BK = 64, HALF = 128, HTB = HALF * BK * 2, NXCD = 8, WGM = 8;
DI int lds_byte(int r, int c) { const int st = (r >> 4) * 2 + (c >> 5), rr = r & 15, cc = c & 31, ob = rr * 64 + cc * 2; return st * 1024 + (ob ^ (((ob >> 9) & 1) << 5)); }
DI void stage_rc(int b, int& R, int& C) { const int st = b / 1024, sb = b % 1024, swz = sb ^ (((sb >> 9) & 1) << 5); R = (st >> 1) * 16 + swz / 64; C = (st & 1) * 32 + (swz % 64) / 2; }
DI int perm32(int rho) { const int n = rho >> 4, i = rho & 15; return 8 * (i >> 2) + 4 * n + (i & 3); }
struct Unit { int pm, pn; };
struct Gemm { const bf16_t* A; const bf16_t* Bt; int M, N, K; };
struct StaticOrder {
    int nM, nN, nwg, G, c, extra;
    DI void init(int M, int N, int G_, int c_, int extra_) { nM = M / BM; nN = N / BM; nwg = nM * nN; G = G_; c = c_; extra = extra_; }
    DI bool next(int i, Unit& u) const {
        const long L = (long)i * G + c; if (L >= nwg + extra) return false;
        if (L >= nwg) { const int q = (int)(L - nwg); u.pm = nM + (q >> 2); u.pn = nN + q; return true; }
        int wgid = (int)L; { const int q = nwg / NXCD, r = nwg % NXCD, xcd = wgid % NXCD, off = wgid / NXCD; wgid = (xcd < r ? xcd * (q + 1) : r * (q + 1) + (xcd - r) * q) + off; }
        const int nig = WGM * nN, gid = wgid / nig, fm = gid * WGM, gsz = (nM - fm) < WGM ? (nM - fm) : WGM;
        u.pm = fm + ((wgid % nig) % gsz); u.pn = (wgid % nig) / gsz; return true;
    }
};

template <class Epi>
DI void gemm_phase(LAS uchar* lds, const Gemm g, const StaticOrder& S, const Epi& E) {
    const int tid = otid(), wid = __builtin_amdgcn_readfirstlane(tid >> 6), lane = tid & 63, wr = wid >> 2, wc = wid & 3, fr = lane & 15, fq = lane >> 4;
    const int K = g.K, nt = K / BK;
    unsigned voffA[2], voffB[2];
#pragma unroll
    for (int i = 0; i < 2; ++i) { int R, C; stage_rc(tid * 16 + i * 8192, R, C); const int Rb = Epi::PERM ? ((R & ~31) + perm32(R & 31)) : R;
        voffA[i] = (unsigned)(R * K + C) * 2u; voffB[i] = (unsigned)(Rb * K + C) * 2u; }
    const size_t kstep = (size_t)(BK * 2);
    const size_t hstep = (size_t)HALF * K * 2;
    const size_t tstep = 2 * hstep;
    const unsigned ldsw = (unsigned)wid * 1024u;
    const int aoff = lds_byte(wr * 64 + fr, fq * 8), boff = lds_byte(wc * 32 + fr, fq * 8);
#define PG8_SA(b, h) (((b) * 2 + (h)) * HTB)
#define PG8_SB(b, h) ((4 + (b) * 2 + (h)) * HTB)
#define PG8_STAGE(bufoff, gbase, voff) do { _Pragma("unroll") for (int _i = 0; _i < 2; ++_i) \
        __builtin_amdgcn_global_load_lds((const unsigned*)((const char*)(gbase) + (voff)[_i]), (LAS unsigned*)(lds + (bufoff) + ldsw + _i * 8192), 16, 0, 0); } while (0)
#define PG8_LDA(dst, b, h) do { _Pragma("unroll") for (int m = 0; m < 4; ++m) _Pragma("unroll") for (int k = 0; k < 2; ++k) dst[m][k] = *(const LAS bf16x8*)(lds + PG8_SA(b, h) + aoff + m * 2048 + k * 1024); } while (0)
#define PG8_LDB(dst, b, h) do { _Pragma("unroll") for (int n = 0; n < 2; ++n) _Pragma("unroll") for (int k = 0; k < 2; ++k) dst[n][k] = *(const LAS bf16x8*)(lds + PG8_SB(b, h) + boff + n * 2048 + k * 1024); } while (0)
#define PG8_MMA(ai, bj, At, Bt) do { __builtin_amdgcn_s_setprio(1); _Pragma("unroll") for (int m = 0; m < 4; ++m) _Pragma("unroll") for (int n = 0; n < 2; ++n) _Pragma("unroll") for (int k = 0; k < 2; ++k) \
        acc[ai][bj][m][n] = __builtin_amdgcn_mfma_f32_16x16x32_bf16(Bt[n][k], At[m][k], acc[ai][bj][m][n], 0, 0, 0); __builtin_amdgcn_s_setprio(0); } while (0)
#define PG8_WAIT_V(n) asm volatile("s_waitcnt vmcnt(" #n ")" ::: "memory")
#define PG8_WAIT_L(n) asm volatile("s_waitcnt lgkmcnt(" #n ")" ::: "memory")
#define PG8_BAR __builtin_amdgcn_s_barrier()
#define PG8_SCHED __builtin_amdgcn_sched_barrier(0)
    Unit cur, nxt; int ui = 0;
    if (!S.next(0, cur)) return;
    f32x4 acc[2][2][4][2];
#pragma unroll
    for (int a = 0; a < 2; ++a)
#pragma unroll
        for (int b = 0; b < 2; ++b)
#pragma unroll
            for (int m = 0; m < 4; ++m)
#pragma unroll
                for (int n = 0; n < 2; ++n) acc[a][b][m][n] = (f32x4){0.f, 0.f, 0.f, 0.f};
    bf16x8 At[4][2], B0[2][2], B1[2][2];
    const char* cA = (const char*)g.A + (size_t)cur.pm * tstep; const char* cB = (const char*)g.Bt + (size_t)cur.pn * tstep;
    PG8_STAGE(PG8_SB(0, 0), cB, voffB); PG8_STAGE(PG8_SA(0, 0), cA, voffA); PG8_STAGE(PG8_SB(0, 1), cB + hstep, voffB); PG8_STAGE(PG8_SA(0, 1), cA + hstep, voffA);
    if (wr == 1) PG8_BAR;
    PG8_WAIT_V(4); PG8_BAR;
    PG8_STAGE(PG8_SB(1, 0), cB + kstep, voffB); PG8_STAGE(PG8_SA(1, 0), cA + kstep, voffA); PG8_STAGE(PG8_SB(1, 1), cB + hstep + kstep, voffB);
    PG8_WAIT_V(6); PG8_BAR;
    for (;;) {
        const bool has_next = S.next(ui + 1, nxt);
        const char* nA = has_next ? (const char*)g.A + (size_t)nxt.pm * tstep : cA; const char* nB = has_next ? (const char*)g.Bt + (size_t)nxt.pn * tstep : cB;
        for (int t = 0; t < nt; t += 2) {
            const bool last = (t == nt - 2);
            const char* a1 = cA + (size_t)(t + 1) * kstep;
            const char* a2 = last ? nA : cA + (size_t)(t + 2) * kstep; const char* b2 = last ? nB : cB + (size_t)(t + 2) * kstep;
            const char* a3 = a2 + kstep; const char* b3 = b2 + kstep;
            PG8_LDB(B0, 0, 0); PG8_SCHED; PG8_LDA(At, 0, 0); PG8_STAGE(PG8_SA(1, 1), a1 + hstep, voffA);
            PG8_WAIT_L(8); PG8_BAR; PG8_WAIT_L(0); PG8_MMA(0, 0, At, B0); PG8_BAR; PG8_SCHED;
            PG8_LDB(B1, 0, 1); PG8_STAGE(PG8_SB(0, 0), b2, voffB);
            PG8_BAR; PG8_WAIT_L(0); PG8_MMA(0, 1, At, B1); PG8_BAR;
            PG8_LDA(At, 0, 1); PG8_STAGE(PG8_SA(0, 0), a2, voffA);
            PG8_BAR; PG8_WAIT_L(0); PG8_MMA(1, 0, At, B0); PG8_BAR; PG8_SCHED;
            PG8_STAGE(PG8_SB(0, 1), b2 + hstep, voffB);
            PG8_WAIT_V(6); PG8_BAR; PG8_MMA(1, 1, At, B1); PG8_BAR;
            PG8_LDB(B0, 1, 0); PG8_SCHED; PG8_LDA(At, 1, 0); PG8_STAGE(PG8_SA(0, 1), a2 + hstep, voffA);
            PG8_WAIT_L(8); PG8_BAR; PG8_WAIT_L(0); PG8_MMA(0, 0, At, B0); PG8_BAR; PG8_SCHED;
            PG8_LDB(B1, 1, 1); PG8_STAGE(PG8_SB(1, 0), b3, voffB);
            PG8_BAR; PG8_WAIT_L(0); PG8_MMA(0, 1, At, B1); PG8_BAR;
            PG8_LDA(At, 1, 1); PG8_STAGE(PG8_SA(1, 0), a3, voffA);
            PG8_BAR; PG8_WAIT_L(0); PG8_MMA(1, 0, At, B0); PG8_BAR; PG8_SCHED;
            PG8_STAGE(PG8_SB(1, 1), b3 + hstep, voffB);
            PG8_WAIT_V(6); PG8_BAR; PG8_MMA(1, 1, At, B1); PG8_BAR;
        }
        E(acc, cur, wr, wc, fr, fq);
        if (!has_next) break;
#pragma unroll
        for (int a = 0; a < 2; ++a)
#pragma unroll
            for (int b = 0; b < 2; ++b)
#pragma unroll
                for (int m = 0; m < 4; ++m)
#pragma unroll
                    for (int n = 0; n < 2; ++n) acc[a][b][m][n] = (f32x4){0.f, 0.f, 0.f, 0.f};
        cur = nxt; cA = nA; cB = nB; ++ui;
    }
    PG8_WAIT_V(0);
    if (wr == 0) PG8_BAR;
    PG8_BAR;
#undef PG8_SA
#undef PG8_SB
#undef PG8_STAGE
#undef PG8_LDA
#undef PG8_LDB
#undef PG8_MMA
#undef PG8_WAIT_V
#undef PG8_WAIT_L
#undef PG8_BAR
#undef PG8_SCHED
}
}
using pg8::Unit;

struct EpiF32 {
    static constexpr bool PERM = false;
    float* C; int ldc;
    DI void operator()(const f32x4 (&acc)[2][2][4][2], const Unit& u, int wr, int wc, int fr, int fq) const {
        const int row0 = u.pm * 256 + wr * 64 + fr, col0 = u.pn * 256 + wc * 32 + 4 * fq;
#pragma unroll
        for (int ai = 0; ai < 2; ++ai)
#pragma unroll
            for (int m = 0; m < 4; ++m) { float* rowp = C + (size_t)(row0 + ai * 128 + m * 16) * ldc + col0;
#pragma unroll
                for (int bj = 0; bj < 2; ++bj)
#pragma unroll
                    for (int n = 0; n < 2; ++n) *(f32x4*)(rowp + bj * 128 + n * 16) = acc[ai][bj][m][n]; }
    }
};

struct EpiO {
    static constexpr bool PERM = true;
    bf16_t* C;
    DI void operator()(const f32x4 (&acc)[2][2][4][2], const Unit& u, int wr, int wc, int fr, int fq) const {
        asm volatile("" : "+v"(fr), "+v"(fq));
        const int row0 = u.pm * 256 + wr * 64 + fr, col0 = u.pn * 256 + wc * 32 + 8 * fq;
#pragma unroll
        for (int ai = 0; ai < 2; ++ai)
#pragma unroll
            for (int m = 0; m < 4; ++m) { bf16_t* rowp = C + (size_t)(row0 + ai * 128 + m * 16) * 2048 + col0;
#pragma unroll
                for (int bj = 0; bj < 2; ++bj) { const f32x4 v0 = acc[ai][bj][m][0], v1 = acc[ai][bj][m][1];
                    *(u32x4*)(rowp + bj * 128) = (u32x4){pk_bf16(v0[0], v0[1]), pk_bf16(v0[2], v0[3]), pk_bf16(v1[0], v1[1]), pk_bf16(v1[2], v1[3])}; } }
    }
};

struct Epi1 {
    static constexpr bool PERM = true;
    bf16_t* P0; bf16_t* memkv; float* out; const float *tAc, *tAs, *tBc, *tBs; bf16_t *kfd, *kfr, *kfm;
    template <int TYPE>
    DI void body(const f32x4 (&acc)[2][2][4][2], const Unit& u, int wr, int wc, int fr, int fq) const {
        const int hp0 = wc * 32 + fq * 8;
#pragma unroll
        for (int ai = 0; ai < 2; ++ai)
#pragma unroll
            for (int m = 0; m < 4; ++m) {
                const int r = u.pm * 256 + ai * 128 + wr * 64 + m * 16 + fr;
                f32x4 cs = {1.f, 1.f, 1.f, 1.f}, sn = {0.f, 0.f, 0.f, 0.f};
                bool rot = false;
                if (TYPE == 0 || TYPE == 1) { cs = *(const f32x4*)(tAc + (size_t)r * 64 + (hp0 >> 1)); sn = *(const f32x4*)(tAs + (size_t)r * 64 + (hp0 >> 1)); rot = true; }
                if ((TYPE == 4 || TYPE == 5) && wc == 0) { cs = *(const f32x4*)(tBc + (size_t)r * 16 + (hp0 >> 1)); sn = *(const f32x4*)(tBs + (size_t)r * 16 + (hp0 >> 1)); rot = true; }
#pragma unroll
                for (int bj = 0; bj < 2; ++bj) {
                    f32x4 v0 = acc[ai][bj][m][0], v1 = acc[ai][bj][m][1];
                    if (TYPE == 0 || TYPE == 1 || TYPE == 4 || TYPE == 5) {
                        if (rot) {
                            f32x4 o0 = {v0[0] * cs[0] - v0[1] * sn[0], v0[1] * cs[0] + v0[0] * sn[0], v0[2] * cs[1] - v0[3] * sn[1], v0[3] * cs[1] + v0[2] * sn[1]};
                            f32x4 o1 = {v1[0] * cs[2] - v1[1] * sn[2], v1[1] * cs[2] + v1[0] * sn[2], v1[2] * cs[3] - v1[3] * sn[3], v1[3] * cs[3] + v1[2] * sn[3]};
                            v0 = o0; v1 = o1;
                        }
                        if (TYPE == 1 || TYPE == 4) { v0 *= RSQ128; v1 *= RSQ128; }
                    }
                    if (TYPE == 3) { for (int j = 0; j < 4; ++j) { v0[j] = silu_f(v0[j]); v1[j] = silu_f(v1[j]); } }
                    if (TYPE == 7) { v0 *= RSQ128; v1 *= RSQ128; }
                    u32x4 w = {pk_bf16(v0[0], v0[1]), pk_bf16(v0[2], v0[3]), pk_bf16(v1[0], v1[1]), pk_bf16(v1[2], v1[3])};
                    *(u32x4*)(P0 + (size_t)r * LD0 + u.pn * 256 + bj * 128 + hp0) = w;
                    if ((TYPE == 1 || TYPE == 5) && r < TP) {
                        const unsigned kh = (unsigned)((hp0 >> 4) * 512 + ((hp0 >> 3) & 1) * 256);
                        if (TYPE == 1) { const unsigned hd = (unsigned)((u.pn - 4) * 2 + bj);
                            *(u32x4*)(kfr + (hd * 1048576u + (unsigned)(r >> 5) * 4096u + kh + (unsigned)(r & 31) * 8u)) = w; }
                        else { const unsigned hd = (unsigned)((u.pn - 28) * 2 + bj);
#pragma unroll
                            for (int b = 0; b < 3; ++b) { const int sh = 2 * b; const unsigned L = (unsigned)r >> sh, res = (unsigned)r & ((1u << sh) - 1u);
                                *(u32x4*)(kfd + ((unsigned)b * 8388608u + hd * 1048576u + (res * (256u >> sh) + (L >> 5)) * 4096u + kh + (L & 31u) * 8u)) = w; } }
                    }
                    if (TYPE == 5 || TYPE == 6) {
                        float* dstrow = nullptr;
                        if (r >= 6144 && r < 8192) dstrow = out + (TYPE == 5 ? O_PSWAK : O_PSWAV) + (size_t)(r - 6144) * 1024;
                        else if (r >= 8192 && r < NROW) dstrow = out + (TYPE == 5 ? O_SSWAK : O_SSWAV) + (size_t)(r - 8192) * 1024;
                        if (dstrow) {
                            const int hd = (u.pn - (TYPE == 5 ? 28 : 32)) * 2 + bj; float* d = dstrow + hd * 128;
                            if (TYPE == 5 && wc == 0) { const int i0 = hp0 >> 1;
                                *(f32x4*)(d + i0) = (f32x4){v0[0], v0[2], v1[0], v1[2]}; *(f32x4*)(d + 16 + i0) = (f32x4){v0[1], v0[3], v1[1], v1[3]}; }
                            else { *(f32x4*)(d + hp0) = v0; *(f32x4*)(d + hp0 + 4) = v1; }
                        }
                    }
                }
                if (TYPE == 1 || TYPE == 5) asm volatile("" ::: "memory");
            }
    }
    DI void operator()(const f32x4 (&acc)[2][2][4][2], const Unit& u, int wr, int wc, int fr, int fq) const {
        asm volatile("" : "+v"(fr), "+v"(fq));
        if (u.pm >= 33) {
            const int layer = u.pm - 33, cn0 = (u.pn - 44 - 4 * layer) * 256, hp0 = wc * 32 + fq * 8;
#pragma unroll
            for (int ai = 0; ai < 2; ++ai)
#pragma unroll
                for (int m = 0; m < 4; ++m) { const int rl = ai * 128 + wr * 64 + m * 16 + fr;
#pragma unroll
                    for (int bj = 0; bj < 2; ++bj) { const f32x4 v0 = acc[ai][bj][m][0], v1 = acc[ai][bj][m][1]; const int col = cn0 + bj * 128 + hp0;
                        u32x4 w = {pk_bf16(v0[0], v0[1]), pk_bf16(v0[2], v0[3]), pk_bf16(v1[0], v1[1]), pk_bf16(v1[2], v1[3])};
                        *(u32x4*)(memkv + (size_t)(layer * 256 + rl) * 1024 + col) = w;
                        if (col < 512) { const int hd = col >> 7, hq = col & 127, ks = hq >> 4, hl = (hq >> 3) & 1;
                            *(u32x4*)(kfm + ((((size_t)(layer * 4 + hd) * 8 + (rl >> 5)) * 8 + ks) * 64 + hl * 32 + (rl & 31)) * 8) = w; }
                        float* d = out + (col < 512 ? O_PMEMK : O_PMEMV) + (size_t)(layer * 256 + rl) * 512 + (col & 511);
                        *(f32x4*)d = v0; *(f32x4*)(d + 4) = v1; } }
            return;
        }
        const int pn = u.pn;
        if (pn < 4) body<0>(acc, u, wr, wc, fr, fq); else if (pn < 8) body<1>(acc, u, wr, wc, fr, fq); else if (pn < 16) body<2>(acc, u, wr, wc, fr, fq);
        else if (pn < 24) body<2>(acc, u, wr, wc, fr, fq); else if (pn < 28) body<4>(acc, u, wr, wc, fr, fq); else if (pn < 32) body<5>(acc, u, wr, wc, fr, fq);
        else if (pn < 36) body<6>(acc, u, wr, wc, fr, fq); else if (pn < 40) body<2>(acc, u, wr, wc, fr, fq); else if (pn < 42) body<7>(acc, u, wr, wc, fr, fq);
        else body<2>(acc, u, wr, wc, fr, fq);
    }
};

struct Epi3 {
    static constexpr bool PERM = true;
    bf16_t* P1; float* lns;
    template <int TYPE>
    DI void body(const f32x4 (&acc)[2][2][4][2], const Unit& u, int wr, int wc, int fr, int fq) const {
        const int hp0 = wc * 32 + fq * 8;
#pragma unroll
        for (int ai = 0; ai < 2; ++ai)
#pragma unroll
            for (int m = 0; m < 4; ++m) {
                const int r = u.pm * 256 + ai * 128 + wr * 64 + m * 16 + fr;
                float s1 = 0.f, s2 = 0.f;
#pragma unroll
                for (int bj = 0; bj < 2; ++bj) {
                    f32x4 v0 = acc[ai][bj][m][0], v1 = acc[ai][bj][m][1];
#pragma unroll
                    for (int j = 0; j < 4; ++j) {
                        if (TYPE == 1) { v0[j] = gelu_f(v0[j]); v1[j] = gelu_f(v1[j]); }
                        if (TYPE == 3) { v0[j] *= RSQ128; v1[j] *= RSQ128; }
                        if (TYPE == 1) { s1 += v0[j] + v1[j]; s2 += v0[j] * v0[j] + v1[j] * v1[j]; }
                    }
                    u32x4 w = {pk_bf16(v0[0], v0[1]), pk_bf16(v0[2], v0[3]), pk_bf16(v1[0], v1[1]), pk_bf16(v1[2], v1[3])};
                    *(u32x4*)(P1 + (size_t)r * LD1 + u.pn * 256 + bj * 128 + hp0) = w;
                }
                if (TYPE == 1) {
                    s1 += __shfl_xor(s1, 16); s2 += __shfl_xor(s2, 16); s1 += __shfl_xor(s1, 32); s2 += __shfl_xor(s2, 32);
                    if (fq == 0) { atomicAdd(lns + 2 * r, s1); atomicAdd(lns + 2 * r + 1, s2); }
                }
            }
    }
    DI void operator()(const f32x4 (&acc)[2][2][4][2], const Unit& u, int wr, int wc, int fr, int fq) const {
        asm volatile("" : "+v"(fr), "+v"(fq));
        const int pn = u.pn;
        if (pn < 8) body<0>(acc, u, wr, wc, fr, fq); else if (pn < 16) body<1>(acc, u, wr, wc, fr, fq); else if (pn < 24) body<0>(acc, u, wr, wc, fr, fq);
        else if (pn < 26) body<3>(acc, u, wr, wc, fr, fq); else body<0>(acc, u, wr, wc, fr, fq);
    }
};

DI int orig_col(int p, int mode) {
    if (mode == 1) {
        const int hp = p & 127, base = p & ~127;
        if (p < 2048) return base + (hp >> 1) + 64 * (hp & 1);
        if (p >= 6144 && p < 8192 && hp < 32) return base + (hp >> 1) + 16 * (hp & 1);
    }
    return p;
}

DI void wconv(const Params& p, LAS uchar* lds, int t_begin, int t_end, int start, int stride) {
    const int tid = otid();
    bf16_t* WT1 = (bf16_t*)(p.ws + W_WT1);
    LAS float* tl = (LAS float*)lds;
    {
        struct WT { const float* src; bf16_t* dst; int K, N, mode, kt, pt; };
        auto decode = [&](int t) { WT r; int tt = t; r.mode = 0;
            if (tt < 2816) { r.src = p.w_in_even; r.dst = WT1; r.K = 2048; r.N = 11264; r.mode = 1; }
            else if ((tt -= 2816) < 896) { r.src = p.w_out_even; r.dst = (bf16_t*)(p.ws + W_WT2); r.K = 3584; r.N = 2048; }
            else if ((tt -= 896) < 1792) { r.src = p.w_in_odd; r.dst = (bf16_t*)(p.ws + W_WT3); r.K = 2048; r.N = 7168; }
            else if ((tt -= 1792) < 640) { r.src = p.w_out_odd; r.dst = (bf16_t*)(p.ws + W_WT4); r.K = 2560; r.N = 2048; }
            else { tt -= 640; const int which = tt >> 7; tt &= 127;
                r.src = ((which & 1) ? p.w_mem_v : p.w_mem_k) + (size_t)(which >> 1) * 2048 * 512; r.dst = WT1 + (size_t)(11264 + which * 512) * 2048; r.K = 2048; r.N = 512; }
            const int nkt = r.K / 64; r.kt = tt % nkt; r.pt = tt / nkt; return r; };
        auto loadt = [&](const WT& r, f32x4 (&v)[4]) {
#pragma unroll
            for (int i = 0; i < 4; ++i) { const int f = tid + 512 * i, row = f >> 5, c4 = f & 31; v[i] = *(const f32x4*)(r.src + (size_t)(r.kt * 64 + row) * r.N + r.pt * 128 + c4 * 4); } };
        f32x4 cur[4], nxt[4], nx2[4];
        const int t0 = t_begin + start;
        if (t0 < t_end) { const WT r0 = decode(t0); loadt(r0, cur); }
        if (t0 + stride < t_end) { const WT r1 = decode(t0 + stride); loadt(r1, nxt); }
        for (int t = t0; t < t_end; t += stride) {
            const WT r = decode(t);
            if (t + 2 * stride < t_end) { const WT rn = decode(t + 2 * stride); loadt(rn, nx2); }
            const int c0 = r.pt * 128; const int pc = r.mode == 1 ? (c0 < 2048 ? 1 : ((c0 >= 6144 && c0 < 8192) ? 2 : 0)) : 0;
#pragma unroll
            for (int i = 0; i < 4; ++i) { const int f = tid + 512 * i, row = f >> 5, c4 = f & 31;
#pragma unroll
                for (int j = 0; j < 4; ++j) { const int d = c4 * 4 + j; const int pp = pc == 1 ? 2 * (d & 63) + (d >> 6) : ((pc == 2 && d < 32) ? 2 * (d & 15) + (d >> 4) : d); tl[row * 129 + pp] = cur[i][j]; } }
            __syncthreads();
#pragma unroll
            for (int i = 0; i < 2; ++i) { const int piece = tid + 512 * i, pp = piece >> 3, kc = piece & 7; float v[8];
#pragma unroll
                for (int j = 0; j < 8; ++j) v[j] = tl[(kc * 8 + j) * 129 + pp];
                u32x4 wv = {pk_bf16(v[0], v[1]), pk_bf16(v[2], v[3]), pk_bf16(v[4], v[5]), pk_bf16(v[6], v[7])};
                *(u32x4*)(r.dst + (size_t)(r.pt * 128 + pp) * r.K + r.kt * 64 + kc * 8) = wv; }
            __syncthreads();
#pragma unroll
            for (int i = 0; i < 4; ++i) { cur[i] = nxt[i]; nxt[i] = nx2[i]; }
        }
    }
}

DI void phase0(const Params& p, LAS uchar* lds) {
    const int tid = otid(), wid = tid >> 6, lane = tid & 63, G = gridDim.x, B = blockIdx.x;
    bf16_t* WT1 = (bf16_t*)(p.ws + W_WT1);
    LAS float* tl = (LAS float*)lds;
    wconv(p, lds, 0, 2816, B, G); wconv(p, lds, 6144, 6656, B, G);
    bf16_t* A0 = (bf16_t*)(p.ws + W_A0);
    for (int row = B * 8 + wid; row < 8960; row += G * 8) {
        bf16_t* dst = A0 + (size_t)row * 2048;
        if (row >= NROW && row < MPAD) { for (int i = 0; i < 8; ++i) *(u32x2*)(dst + (i * 64 + lane) * 4) = (u32x2){0u, 0u}; continue; }
        const float* src; const float* g;
        if (row < TP) { src = p.x_prompt + (size_t)row * 2048; g = p.pre_norm; }
        else if (row < NROW) { src = p.x_sample + (size_t)(row - TP) * 2048; g = p.pre_norm; }
        else { const int q = row - MPAD; src = p.mem_prompt + (size_t)(q & 255) * 2048; g = p.mem_norm + (q >> 8) * 2048; }
        f32x4 v[8]; float ss = 0.f;
#pragma unroll
        for (int i = 0; i < 8; ++i) { v[i] = *(const f32x4*)(src + (i * 64 + lane) * 4); ss += v[i][0] * v[i][0] + v[i][1] * v[i][1] + v[i][2] * v[i][2] + v[i][3] * v[i][3]; }
        ss = wave_sum(ss); const float rs = rsqrtf(ss * (1.f / 2048.f) + 1e-6f);
#pragma unroll
        for (int i = 0; i < 8; ++i) { const f32x4 gg = *(const f32x4*)(g + (i * 64 + lane) * 4);
            *(u32x2*)(dst + (i * 64 + lane) * 4) = (u32x2){pk_bf16(v[i][0] * rs * gg[0], v[i][1] * rs * gg[1]), pk_bf16(v[i][2] * rs * gg[2], v[i][3] * rs * gg[3])}; }
    }
    float* tAc = (float*)(p.ws + W_TAC); float* tAs = (float*)(p.ws + W_TAS); float* tBc = (float*)(p.ws + W_TBC); float* tBs = (float*)(p.ws + W_TBS);
    for (int idx = B * 512 + tid; idx < MPAD * 80; idx += G * 512) {
        const int row = idx / 80, e = idx - row * 80;
        const int pos = row < TP ? row : (row < NROW ? TP + ((row - TP) & 3) : 0);
        if (e < 64) { const float inv = 1.0f / powf(10000.0f, (float)e * (1.f / 64.f)); const float ang = (float)pos * inv; tAc[row * 64 + e] = cosf(ang); tAs[row * 64 + e] = sinf(ang); }
        else { const int i = e - 64; const float inv = 1.0f / powf(500000.0f, (float)i * (1.f / 16.f)); const float ang = (float)pos * inv; tBc[row * 16 + i] = cosf(ang); tBs[row * 16 + i] = sinf(ang); }
    }
    bf16_t* WC = (bf16_t*)(p.ws + W_WC);
    for (int idx = B * 512 + tid; idx < 16 * 128 * 128; idx += G * 512) { const int s = idx & 127, t = (idx >> 7) & 127; WC[idx] = f2bf(s <= t ? p.w_spatial[idx] : 0.f); }
    float* lns = (float*)(p.ws + W_LNS);
    for (int idx = B * 512 + tid; idx < MPAD * 2; idx += G * 512) lns[idx] = 0.f;
}

DI void load_kfm(bf16x8 (&kf)[8], const bf16_t* chunk, int lane) {
#pragma unroll
    for (int ks = 0; ks < 8; ++ks) kf[ks] = *(const bf16x8*)(chunk + (size_t)(ks * 64 + lane) * 8);
}
DI void load_kf(bf16x8 (&kf)[8], const bf16_t* kp) {
#pragma unroll
    for (int ks = 0; ks < 8; ++ks) kf[ks] = *(const bf16x8*)(kp + 16 * ks);
}
DI void flash_chunk(const bf16x8 (&qf)[8], const bf16x8 (&kf)[8], int maskmode, LAS uchar* vbase, int RS, int lrow0, int lane, float& m, float& l, f32x16 (&O)[4]) {
    const int rl = lane & 31, h = lane >> 5;
    f32x16 s; for (int i = 0; i < 16; ++i) s[i] = 0.f;
#pragma unroll
    for (int ks = 0; ks < 8; ++ks) s = MFMA32(kf[ks], qf[ks], s);
    if (maskmode != 0) {
        const int mlo = maskmode == 2 ? 0 : -64, mhi = maskmode == 1 ? 0 : 64;
#pragma unroll
        for (int i = 0; i < 16; ++i) { const int dd = rl - crow(i, h); s[i] = ((dd >= mlo) & (dd <= mhi)) ? s[i] : -1e30f; }
    }
    float mx = s[0];
#pragma unroll
    for (int i = 1; i < 16; ++i) mx = fmaxf(mx, s[i]);
    mx = fmaxf(mx, __shfl_xor(mx, 32));
    const float mn = fmaxf(m, mx), alpha = __builtin_amdgcn_exp2f((m - mn) * 1.4426950408889634f), nm = -mn * 1.4426950408889634f; m = mn;
    float ls = 0.f;
#pragma unroll
    for (int i = 0; i < 16; ++i) { s[i] = __builtin_amdgcn_exp2f(fmaf(s[i], 1.4426950408889634f, nm)); ls += s[i]; }
    l = l * alpha + ls;
#pragma unroll
    for (int dt = 0; dt < 4; ++dt) O[dt] *= alpha;
    const bf16x8 pf0 = pack8(s[0], s[1], s[2], s[3], s[4], s[5], s[6], s[7]), pf1 = pack8(s[8], s[9], s[10], s[11], s[12], s[13], s[14], s[15]);
#pragma unroll
    for (int dt = 0; dt < 4; ++dt) {
        const bf16x8 v0 = tr_frag(vbase, RS, lrow0 + 4 * h, lrow0 + 8 + 4 * h, 32 * dt, lane);
        O[dt] = MFMA32(v0, pf0, O[dt]);
        const bf16x8 v1 = tr_frag(vbase, RS, lrow0 + 16 + 4 * h, lrow0 + 24 + 4 * h, 32 * dt, lane);
        O[dt] = MFMA32(v1, pf1, O[dt]);
    }
}

DI void dil_tile(const Params& p, int item, LAS uchar* lds) {
    const int tid = otid(), w = tid >> 6, lane = tid & 63, rl = lane & 31, h = lane >> 5;
    const bf16_t* P0 = (const bf16_t*)(p.ws + W_P0);
    const int branch = item >> 8, rem = item & 255, hd = rem & 7, tb = rem >> 3;
    const int r = branch == 0 ? 1 : (branch == 1 ? 4 : 16), ppr = 32 / r, res = tb / ppr, n0 = 2 * (tb % ppr);
    const int RS = 320;
#pragma unroll
    for (int i = 0; i < 12; ++i) { const int piece = tid + 512 * i, row = piece >> 4, c16 = piece & 15; const int Lk = (n0 - 1) * 128 + row;
        if (Lk >= 0) { const size_t pos = (size_t)Lk * r + res; *(LAS u32x4*)(lds + row * RS + c16 * 16) = *(const u32x4*)(P0 + pos * LD0 + 8192 + hd * 128 + c16 * 8); } }
    const int Lq = n0 * 128 + 32 * w + rl; const size_t posq = (size_t)Lq * r + res;
    bf16x8 qf[8];
#pragma unroll
    for (int ks = 0; ks < 8; ++ks) qf[ks] = *(const bf16x8*)(P0 + posq * LD0 + 6144 + hd * 128 + 16 * ks + 8 * h);
    const int c0 = n0 > 0 ? 0 : (4 - w > 0 ? 4 - w : 0);
    const bf16_t* KFD = (const bf16_t*)(p.ws + W_KFD) + (size_t)branch * 8192 * 1024 + ((size_t)(hd * r + res) * (256 / r)) * 4096;
    auto kptr = [&](int c) { const int Lk0 = n0 * 128 + 32 * w - 128 + 32 * c; return KFD + (size_t)(Lk0 >> 5) * 4096; };
    bf16x8 kfA[8], kfB[8];
    load_kfm(kfA, kptr(c0), lane);
    __syncthreads();
    f32x16 O[4]; for (int dt = 0; dt < 4; ++dt) for (int i = 0; i < 16; ++i) O[dt][i] = 0.f;
    float m = -1e30f, l = 0.f;
    for (int c = c0;;) {
        load_kfm(kfB, kptr(c < 4 ? c + 1 : 4), lane); __builtin_amdgcn_sched_barrier(0);
        flash_chunk(qf, kfA, c == 0 ? 1 : (c == 4 ? 2 : 0), lds, RS, 32 * w + 32 * c, lane, m, l, O);
        if (++c >= 5) break;
        load_kfm(kfA, kptr(c < 4 ? c + 1 : 4), lane); __builtin_amdgcn_sched_barrier(0);
        flash_chunk(qf, kfB, c == 0 ? 1 : (c == 4 ? 2 : 0), lds, RS, 32 * w + 32 * c, lane, m, l, O);
        if (++c >= 5) break;
    }
    l += __shfl_xor(l, 32);
    const float inv = 1.f / l;
    bf16_t* DO = (bf16_t*)(p.ws + W_DILO) + ((size_t)branch * 8192 + posq) * 1024 + hd * 128;
#pragma unroll
    for (int dt = 0; dt < 4; ++dt)
#pragma unroll
        for (int g4 = 0; g4 < 4; ++g4) { const int d0 = 32 * dt + 8 * g4 + 4 * h;
            *(u32x2*)(DO + d0) = (u32x2){pk_bf16(O[dt][4 * g4] * inv, O[dt][4 * g4 + 1] * inv), pk_bf16(O[dt][4 * g4 + 2] * inv, O[dt][4 * g4 + 3] * inv)}; }
    if (h == 0) { ((float*)(p.ws + W_DILM))[((size_t)branch * 8192 + posq) * 8 + hd] = m; ((float*)(p.ws + W_DILL))[((size_t)branch * 8192 + posq) * 8 + hd] = l; }
    __syncthreads();
}

DI void memp_tile(const Params& p, int item, int layer, LAS uchar* lds) {
    const int tid = otid(), w = tid >> 6, lane = tid & 63, rl = lane & 31, h = lane >> 5;
    const bf16_t* PX = (const bf16_t*)(p.ws + (layer ? W_P1 : W_P0)); const int ld = layer ? LD1 : LD0, qcol = layer ? 6144 : 10240, gcol = layer ? 6656 : 10752;
    bf16_t* CAT = (bf16_t*)(p.ws + (layer ? W_CAT1 : W_CAT0)); const int ldc = layer ? LDC1 : LDC0, ccol = layer ? 2048 : 3072;
    const bf16_t* MKV = (const bf16_t*)(p.ws + W_MEMKV) + (size_t)layer * 256 * 1024;
    const int qt = item >> 2, hd = item & 3; const int RS = 320;
#pragma unroll
    for (int i = 0; i < 8; ++i) { const int piece = tid + 512 * i, row = piece >> 4, c16 = piece & 15;
        *(LAS u32x4*)(lds + row * RS + c16 * 16) = *(const u32x4*)(MKV + (size_t)row * 1024 + 512 + hd * 128 + c16 * 8); }
    const size_t posq = (size_t)qt * 256 + 32 * w + rl;
    bf16x8 qf[8];
#pragma unroll
    for (int ks = 0; ks < 8; ++ks) qf[ks] = *(const bf16x8*)(PX + posq * ld + qcol + hd * 128 + 16 * ks + 8 * h);
    bf16x8 kfA[8], kfB[8];
    const bf16_t* KFM = (const bf16_t*)(p.ws + W_KFM) + (size_t)(layer * 4 + hd) * 8 * 4096;
    load_kfm(kfA, KFM, lane);
    __syncthreads();
    f32x16 O[4]; for (int dt = 0; dt < 4; ++dt) for (int i = 0; i < 16; ++i) O[dt][i] = 0.f;
    float m = -1e30f, l = 0.f;
    for (int c = 0; c < 8; c += 2) {
        load_kfm(kfB, KFM + (size_t)(c + 1) * 4096, lane); __builtin_amdgcn_sched_barrier(0);
        flash_chunk(qf, kfA, 0, lds, RS, 32 * c, lane, m, l, O);
        load_kfm(kfA, KFM + (size_t)(c < 6 ? c + 2 : 7) * 4096, lane); __builtin_amdgcn_sched_barrier(0);
        flash_chunk(qf, kfB, 0, lds, RS, 32 * (c + 1), lane, m, l, O);
    }
    l += __shfl_xor(l, 32);
    const float inv = 1.f / l;
#pragma unroll
    for (int dt = 0; dt < 4; ++dt)
#pragma unroll
        for (int g4 = 0; g4 < 4; ++g4) { const int d0 = 32 * dt + 8 * g4 + 4 * h;
            const u32x2 gt = *(const u32x2*)(PX + posq * ld + gcol + hd * 128 + d0);
            *(u32x2*)(CAT + posq * ldc + ccol + hd * 128 + d0) = (u32x2){pk_bf16(O[dt][4 * g4] * inv * silu_f(bf_lo(gt[0])), O[dt][4 * g4 + 1] * inv * silu_f(bf_hi(gt[0]))),
                                                                       pk_bf16(O[dt][4 * g4 + 2] * inv * silu_f(bf_lo(gt[1])), O[dt][4 * g4 + 3] * inv * silu_f(bf_hi(gt[1])))}; }
    __syncthreads();
}

DI void reta_tile(const Params& p, int item, LAS uchar* lds) {
    const int tid = otid(), w = tid >> 6, lane = tid & 63, rl = lane & 31, h = lane >> 5;
    const bf16_t* P0 = (const bf16_t*)(p.ws + W_P0);
    const int c = item >> 3, hd = item & 7; const float lg = log1pf(-exp2f(-5.f - (float)hd));
    LAS uchar* Kl = lds; LAS uchar* Vl = lds + 40960;
#pragma unroll
    for (int i = 0; i < 4; ++i) { const int piece = tid + 512 * i, j = piece >> 4, c16 = piece & 15;
        const u32x4 raw = *(const u32x4*)(P0 + (size_t)(c * 128 + j) * LD0 + 1024 + hd * 128 + c16 * 8); const float dec = __expf(lg * (float)(127 - j));
        u32x4 o; for (int q = 0; q < 4; ++q) o[q] = pk_bf16(bf_lo(raw[q]) * dec, bf_hi(raw[q]) * dec);
        *(LAS u32x4*)(Kl + j * 320 + c16 * 16) = o; }
#pragma unroll
    for (int i = 0; i < 8; ++i) { const int piece = tid + 512 * i, j = piece >> 5, c16 = piece & 31;
        *(LAS u32x4*)(Vl + j * 576 + c16 * 16) = *(const u32x4*)(P0 + (size_t)(c * 128 + j) * LD0 + 2048 + hd * 256 + c16 * 8); }
    __syncthreads();
    f32x16 acc[4]; for (int dt = 0; dt < 4; ++dt) for (int i = 0; i < 16; ++i) acc[dt][i] = 0.f;
#pragma unroll
    for (int ks = 0; ks < 8; ++ks) { const bf16x8 a = tr_frag(Vl, 576, 16 * ks + 8 * h, 16 * ks + 8 * h + 4, 32 * w, lane);
#pragma unroll
        for (int dt = 0; dt < 4; ++dt) { const bf16x8 b = tr_frag(Kl, 320, 16 * ks + 8 * h, 16 * ks + 8 * h + 4, 32 * dt, lane); acc[dt] = MFMA32(a, b, acc[dt]); } }
    bf16_t* KVT = (bf16_t*)(p.ws + W_KVT) + (size_t)(c * 8 + hd) * 256 * 128;
#pragma unroll
    for (int dt = 0; dt < 4; ++dt)
#pragma unroll
        for (int i = 0; i < 16; ++i) KVT[(size_t)(32 * w + crow(i, h)) * 128 + 32 * dt + rl] = f2bf(acc[dt][i]);
    __syncthreads();
}

DI void retc_tile(const Params& p, int item, LAS uchar* lds) {
    const int tid = otid(), w = tid >> 6, lane = tid & 63, rl = lane & 31, h = lane >> 5;
    const bf16_t* P0 = (const bf16_t*)(p.ws + W_P0);
    const int c = item >> 3, hd = item & 7; const float lg = log1pf(-exp2f(-5.f - (float)hd));
    LAS uchar* Vl = lds; LAS float* red = (LAS float*)(lds + 73728);
#pragma unroll
    for (int i = 0; i < 8; ++i) { const int piece = tid + 512 * i, j = piece >> 5, c16 = piece & 31;
        *(LAS u32x4*)(Vl + j * 576 + c16 * 16) = *(const u32x4*)(P0 + (size_t)(c * 128 + j) * LD0 + 2048 + hd * 256 + c16 * 8); }
    __syncthreads();
    const int qg = w & 3, eh = w >> 2, qi = 32 * qg + rl; const size_t posq = (size_t)c * 128 + qi;
    bf16x8 qf[8];
#pragma unroll
    for (int ks = 0; ks < 8; ++ks) qf[ks] = *(const bf16x8*)(P0 + posq * LD0 + hd * 128 + 16 * ks + 8 * h);
    f32x16 acc[4]; for (int et = 0; et < 4; ++et) for (int i = 0; i < 16; ++i) acc[et][i] = 0.f;
    if (c > 0) {
        const bf16_t* ST = (const bf16_t*)(p.ws + W_STB) + (size_t)(c * 8 + hd) * 256 * 128;
#pragma unroll
        for (int ks = 0; ks < 8; ++ks)
#pragma unroll
            for (int et = 0; et < 4; ++et) { const bf16x8 a = *(const bf16x8*)(ST + (size_t)(128 * eh + 32 * et + rl) * 128 + 16 * ks + 8 * h); acc[et] = MFMA32(a, qf[ks], acc[et]); }
        const float qd = __expf(lg * (float)(qi + 1));
#pragma unroll
        for (int et = 0; et < 4; ++et) acc[et] *= qd;
    }
    bf16x8 kf[8], kfn[8];
    const bf16_t* KFR = (const bf16_t*)(p.ws + W_KFR) + ((size_t)hd * 256 + c * 4) * 4096;
    auto kptr = [&](int jc) { return KFR + (size_t)(jc < qg ? jc : qg) * 4096; };
    auto chunk = [&](const bf16x8 (&kk)[8], int jc) {
        f32x16 s; for (int i = 0; i < 16; ++i) s[i] = 0.f;
#pragma unroll
        for (int ks = 0; ks < 8; ++ks) s = MFMA32(kk[ks], qf[ks], s);
#pragma unroll
        for (int i = 0; i < 16; ++i) { const int diff = qi - (32 * jc + crow(i, h)); s[i] = diff >= 0 ? s[i] * __expf(lg * (float)diff) : 0.f; }
        const bf16x8 pf0 = pack8(s[0], s[1], s[2], s[3], s[4], s[5], s[6], s[7]), pf1 = pack8(s[8], s[9], s[10], s[11], s[12], s[13], s[14], s[15]);
#pragma unroll
        for (int et = 0; et < 4; ++et) {
            const bf16x8 a0 = tr_frag(Vl, 576, 32 * jc + 4 * h, 32 * jc + 8 + 4 * h, 128 * eh + 32 * et, lane); acc[et] = MFMA32(a0, pf0, acc[et]);
            const bf16x8 a1 = tr_frag(Vl, 576, 32 * jc + 16 + 4 * h, 32 * jc + 24 + 4 * h, 128 * eh + 32 * et, lane); acc[et] = MFMA32(a1, pf1, acc[et]);
        }
    };
    load_kfm(kf, kptr(0), lane);
    for (int jc = 0;;) {
        load_kfm(kfn, kptr(jc + 1), lane); __builtin_amdgcn_sched_barrier(0);
        chunk(kf, jc);
        if (++jc > qg) break;
        load_kfm(kf, kptr(jc + 1), lane); __builtin_amdgcn_sched_barrier(0);
        chunk(kfn, jc);
        if (++jc > qg) break;
    }
    float s1 = 0.f, s2 = 0.f;
#pragma unroll
    for (int et = 0; et < 4; ++et)
#pragma unroll
        for (int i = 0; i < 16; ++i) { const float v = acc[et][i]; s1 += v; s2 += v * v; }
    s1 += __shfl_xor(s1, 32); s2 += __shfl_xor(s2, 32);
    if (h == 0) { red[(w * 32 + rl) * 2] = s1; red[(w * 32 + rl) * 2 + 1] = s2; }
    __syncthreads();
    const float t1 = s1 + red[((w ^ 4) * 32 + rl) * 2], t2 = s2 + red[((w ^ 4) * 32 + rl) * 2 + 1];
    const float mu = t1 * (1.f / 256.f), var = t2 * (1.f / 256.f) - mu * mu, rstd = rsqrtf(fmaxf(var, 0.f) + 1e-6f);
    bf16_t* CAT0 = (bf16_t*)(p.ws + W_CAT0);
#pragma unroll
    for (int et = 0; et < 4; ++et)
#pragma unroll
        for (int g4 = 0; g4 < 4; ++g4) { const int e0 = 128 * eh + 32 * et + 8 * g4 + 4 * h;
            const f32x4 gn = *(const f32x4*)(p.ret_gn + hd * 256 + e0); const u32x2 gt = *(const u32x2*)(P0 + posq * LD0 + 4096 + hd * 256 + e0);
            const float y0 = (acc[et][4 * g4] - mu) * rstd * gn[0] * silu_f(bf_lo(gt[0])), y1 = (acc[et][4 * g4 + 1] - mu) * rstd * gn[1] * silu_f(bf_hi(gt[0]));
            const float y2 = (acc[et][4 * g4 + 2] - mu) * rstd * gn[2] * silu_f(bf_lo(gt[1])), y3 = (acc[et][4 * g4 + 3] - mu) * rstd * gn[3] * silu_f(bf_hi(gt[1]));
            *(u32x2*)(CAT0 + posq * LDC0 + hd * 256 + e0) = (u32x2){pk_bf16(y0, y1), pk_bf16(y2, y3)}; }
    __syncthreads();
}

DI void gate_tile(const Params& p, int item, LAS uchar* lds) {
    const int tid = otid(), w = tid >> 6, lane = tid & 63, rl = lane & 31, h = lane >> 5;
    const bf16_t* P1 = (const bf16_t*)(p.ws + W_P1); const float* lns = (const float*)(p.ws + W_LNS);
    const int c = item >> 3, gp = item & 7, ch0 = gp * 256;
    LAS uchar* Vl = lds;
#pragma unroll
    for (int i = 0; i < 8; ++i) { const int piece = tid + 512 * i, s = piece >> 5, c16 = piece & 31; const int pos = c * 128 + s;
        const u32x4 raw = *(const u32x4*)(P1 + (size_t)pos * LD1 + 2048 + ch0 + c16 * 8);
        const float mu = lns[2 * pos] * (1.f / 2048.f), var = lns[2 * pos + 1] * (1.f / 2048.f) - mu * mu, rstd = rsqrtf(fmaxf(var, 0.f) + 1e-6f);
        const f32x4 g0 = *(const f32x4*)(p.gmlp_ln + ch0 + c16 * 8), g1 = *(const f32x4*)(p.gmlp_ln + ch0 + c16 * 8 + 4);
        f32x4 a = {(bf_lo(raw[0]) - mu) * rstd * g0[0], (bf_hi(raw[0]) - mu) * rstd * g0[1], (bf_lo(raw[1]) - mu) * rstd * g0[2], (bf_hi(raw[1]) - mu) * rstd * g0[3]};
        f32x4 b = {(bf_lo(raw[2]) - mu) * rstd * g1[0], (bf_hi(raw[2]) - mu) * rstd * g1[1], (bf_lo(raw[3]) - mu) * rstd * g1[2], (bf_hi(raw[3]) - mu) * rstd * g1[3]};
        *(LAS u32x4*)(Vl + s * 576 + c16 * 16) = (u32x4){pk_bf16(a[0], a[1]), pk_bf16(a[2], a[3]), pk_bf16(b[0], b[1]), pk_bf16(b[2], b[3])};
        if (c == 63) { float* d = p.out + O_PGV + (size_t)s * 2048 + ch0 + c16 * 8; *(f32x4*)d = a; *(f32x4*)(d + 4) = b; } }
    __syncthreads();
    const int g = 2 * gp + (w >> 2), tq = w & 3;
    const bf16_t* WC = (const bf16_t*)(p.ws + W_WC) + (size_t)g * 128 * 128;
    f32x16 acc[4]; for (int n = 0; n < 4; ++n) for (int i = 0; i < 16; ++i) acc[n][i] = 0.f;
    for (int ks = 0; ks < 2 * tq + 2; ++ks) {
        const bf16x8 a = *(const bf16x8*)(WC + (size_t)(32 * tq + rl) * 128 + 16 * ks + 8 * h);
#pragma unroll
        for (int n = 0; n < 4; ++n) { const bf16x8 b = tr_frag(Vl, 576, 16 * ks + 8 * h, 16 * ks + 8 * h + 4, 128 * (w >> 2) + 32 * n, lane); acc[n] = MFMA32(a, b, acc[n]); }
    }
    bf16_t* CAT1 = (bf16_t*)(p.ws + W_CAT1);
    __syncthreads();
#pragma unroll
    for (int n = 0; n < 4; ++n)
#pragma unroll
        for (int i = 0; i < 16; ++i) { const int t = 32 * tq + crow(i, h);
            *(LAS bf16_t*)(Vl + t * 528 + (128 * (w >> 2) + 32 * n + rl) * 2) = f2bf(acc[n][i] + p.b_spatial[g * 128 + t]); }
    __syncthreads();
#pragma unroll
    for (int i = 0; i < 8; ++i) { const int piece = tid + 512 * i, t = piece >> 5, c16 = piece & 31; const size_t pos = (size_t)c * 128 + t;
        const u32x4 mx = *(LAS const u32x4*)(Vl + t * 528 + c16 * 16);
        const u32x4 uu = *(const u32x4*)(P1 + pos * LD1 + ch0 + c16 * 8), zz = *(const u32x4*)(P1 + pos * LD1 + 4096 + ch0 + c16 * 8); u32x4 r;
#pragma unroll
        for (int q = 0; q < 4; ++q) r[q] = pk_bf16(gelu_f(bf_lo(uu[q])) * bf_lo(mx[q]) * silu_f(bf_lo(zz[q])), gelu_f(bf_hi(uu[q])) * bf_hi(mx[q]) * silu_f(bf_hi(zz[q])));
        *(u32x4*)(CAT1 + pos * LDC1 + ch0 + c16 * 8) = r; }
    __syncthreads();
}

template <int HS>
DI void mini_gemm(const bf16_t* A, const bf16_t* Wt, float*  , bf16_t* O, LAS uchar* lds) {
    const int tid = otid(), w = tid >> 6, lane = tid & 63, rl = lane & 31, h = lane >> 5;
    constexpr int K = HS * 2 * 16 * 8;
    LAS float* red = (LAS float*)lds;
    for (int tile = blockIdx.x; tile < 256; tile += gridDim.x) {
        const int mt = tile & 3, nt = tile >> 2, k0 = w * (K >> 3);
        f32x16 acc; for (int i = 0; i < 16; ++i) acc[i] = 0.f;
        const bf16_t* ap = A + (size_t)(32 * mt + rl) * K + k0 + 8 * h; const bf16_t* bp = Wt + (size_t)(32 * nt + rl) * K + k0 + 8 * h;
#pragma unroll
        for (int half = 0; half < 2; ++half) {
            bf16x8 a[HS], b[HS];
#pragma unroll
            for (int q = 0; q < HS; ++q) { a[q] = *(const bf16x8*)(ap + 16 * (half * HS + q)); b[q] = *(const bf16x8*)(bp + 16 * (half * HS + q)); }
#pragma unroll
            for (int q = 0; q < HS; ++q) acc = MFMA32(a[q], b[q], acc);
        }
#pragma unroll
        for (int i = 0; i < 16; ++i) red[w * 1024 + i * 64 + lane] = acc[i];
        __syncthreads();
#pragma unroll
        for (int q = 0; q < 2; ++q) { const int idx = tid + 512 * q, i = idx >> 6, ln = idx & 63; float sum = 0.f;
#pragma unroll
            for (int ww = 0; ww < 8; ++ww) sum += red[ww * 1024 + idx];
            O[(size_t)(32 * mt + crow(i, ln >> 5)) * 2048 + 32 * nt + (ln & 31)] = f2bf(sum); }
        __syncthreads();
    }
}

template <class KF, class VF>
DI void wave_attn(LAS const float* q, int j0, int j1, KF krow, VF vrow, int lane, float& m, float& l, float (&a)[8]) {
    const int kg = lane >> 4, ds = lane & 15;
    const f32x4 q0 = *(LAS const f32x4*)(q + ds * 8), q1 = *(LAS const f32x4*)(q + ds * 8 + 4);
    for (int jb = j0; jb < j1; jb += 64) {
        float part[16];
#pragma unroll
        for (int i = 0; i < 16; ++i) { int j = jb + kg * 16 + i; j = j < j1 ? j : j1 - 1; const float* kp = krow(j) + ds * 8;
            const f32x4 k0 = *(const f32x4*)kp, k1 = *(const f32x4*)(kp + 4);
            part[i] = k0[0] * q0[0] + k0[1] * q0[1] + k0[2] * q0[2] + k0[3] * q0[3] + k1[0] * q1[0] + k1[1] * q1[1] + k1[2] * q1[2] + k1[3] * q1[3]; }
        float v8[8], v4[4], v2[2], s;
        { const bool hi = (ds & 8) != 0;
#pragma unroll
            for (int t = 0; t < 8; ++t) { const float send = hi ? part[t] : part[t + 8], keep = hi ? part[t + 8] : part[t]; v8[t] = keep + __shfl_xor(send, 8); } }
        { const bool hi = (ds & 4) != 0;
#pragma unroll
            for (int t = 0; t < 4; ++t) { const float send = hi ? v8[t] : v8[t + 4], keep = hi ? v8[t + 4] : v8[t]; v4[t] = keep + __shfl_xor(send, 4); } }
        { const bool hi = (ds & 2) != 0;
#pragma unroll
            for (int t = 0; t < 2; ++t) { const float send = hi ? v4[t] : v4[t + 2], keep = hi ? v4[t + 2] : v4[t]; v2[t] = keep + __shfl_xor(send, 2); } }
        { const bool hi = (ds & 1) != 0; const float send = hi ? v2[0] : v2[1], keep = hi ? v2[1] : v2[0]; s = keep + __shfl_xor(send, 1); }
        const bool valid = (jb + lane) < j1; s = valid ? s : -1e30f;
        const float mx = wave_max(s), mn = fmaxf(m, mx), alpha = __expf(m - mn); m = mn;
        const float pv = valid ? __expf(s - mn) : 0.f; l = l * alpha + wave_sum(pv);
#pragma unroll
        for (int t = 0; t < 8; ++t) a[t] *= alpha;
#pragma unroll
        for (int i = 0; i < 16; ++i) { int j = jb + kg * 16 + i; j = j < j1 ? j : j1 - 1; const float pj = __shfl(pv, kg * 16 + i); const float* vp = vrow(j) + ds * 8;
            const f32x4 x0 = *(const f32x4*)vp, x1 = *(const f32x4*)(vp + 4);
            a[0] += pj * x0[0]; a[1] += pj * x0[1]; a[2] += pj * x0[2]; a[3] += pj * x0[3]; a[4] += pj * x1[0]; a[5] += pj * x1[1]; a[6] += pj * x1[2]; a[7] += pj * x1[3]; }
    }
#pragma unroll
    for (int t = 0; t < 8; ++t) { a[t] += __shfl_xor(a[t], 16); a[t] += __shfl_xor(a[t], 32); }
}

DI void attn_merge_store(LAS float* mg, int t, int part, int lane, float m, float l, const float (&a)[8], const bf16_t* gate, bf16_t* dst) {
    if (part == 1 && lane < 16) { LAS float* o = mg + (t * 16 + lane) * 12; o[0] = m; o[1] = l;
#pragma unroll
        for (int q = 0; q < 8; ++q) o[2 + q] = a[q]; }
    __syncthreads();
    if (part == 0 && lane < 16) { LAS const float* o = mg + (t * 16 + lane) * 12; const float M = fmaxf(m, o[0]), w1 = __expf(m - M), w2 = __expf(o[0] - M);
        const float den = 1.f / (w1 * l + w2 * o[1]); const u32x4 gt = *(const u32x4*)(gate + 8 * lane); u32x4 r;
#pragma unroll
        for (int q = 0; q < 4; ++q) r[q] = pk_bf16((w1 * a[2 * q] + w2 * o[2 + 2 * q]) * den * silu_f(bf_lo(gt[q])), (w1 * a[2 * q + 1] + w2 * o[3 + 2 * q]) * den * silu_f(bf_hi(gt[q])));
        *(u32x4*)(dst + 8 * lane) = r; }
    __syncthreads();
}

DI void sdil_item(const Params& p, int item, LAS uchar* lds) {
    const int tid = otid(), w = tid >> 6, lane = tid & 63;
    const bf16_t* P0 = (const bf16_t*)(p.ws + W_P0);
    const int b = item >> 3, hd = item & 7, t = w & 3, part = w >> 2; const size_t R = TP + b * 4 + t;
    LAS float* q = (LAS float*)(lds + w * 512); LAS float* mg = (LAS float*)(lds + 4096);
    for (int dd = lane; dd < 128; dd += 64) { const int pp = dd < 32 ? 2 * (dd & 15) + (dd >> 4) : dd; q[dd] = bf2f(P0[R * LD0 + 6144 + hd * 128 + pp]); }
    __syncthreads();
    const float* newk = p.out + O_SSWAK; const float* newv = p.out + O_SSWAV;
    auto idxf = [&](int jm) { const int br = jm >> 7, j = (jm & 127) + 1; return 2048 + t - (j << (2 * br)); };
    auto krow = [&](int jm) { const int idx = idxf(jm); return idx >= 2048 ? newk + ((size_t)(b * 4 + idx - 2048) * 8 + hd) * 128 : p.cache_k + ((size_t)(b * 2048 + idx) * 8 + hd) * 128; };
    auto vrow = [&](int jm) { const int idx = idxf(jm); return idx >= 2048 ? newv + ((size_t)(b * 4 + idx - 2048) * 8 + hd) * 128 : p.cache_v + ((size_t)(b * 2048 + idx) * 8 + hd) * 128; };
    float m = -1e30f, l = 0.f, a[8] = {0.f, 0.f, 0.f, 0.f, 0.f, 0.f, 0.f, 0.f};
    const int ds = lane & 15;
    const float* ks = newk + ((size_t)(b * 4 + t) * 8 + hd) * 128 + ds * 8; const float* vs = newv + ((size_t)(b * 4 + t) * 8 + hd) * 128 + ds * 8;
    wave_attn(q, part * 192, part * 192 + 192, krow, vrow, lane, m, l, a);
    if (part == 0) {
        const f32x4 ks0 = *(const f32x4*)ks, ks1 = *(const f32x4*)(ks + 4), vs0 = *(const f32x4*)vs, vs1 = *(const f32x4*)(vs + 4);
        const f32x4 q0 = *(LAS const f32x4*)(q + ds * 8), q1 = *(LAS const f32x4*)(q + ds * 8 + 4);
        float sd = ks0[0] * q0[0] + ks0[1] * q0[1] + ks0[2] * q0[2] + ks0[3] * q0[3] + ks1[0] * q1[0] + ks1[1] * q1[1] + ks1[2] * q1[2] + ks1[3] * q1[3];
        sd += __shfl_xor(sd, 1); sd += __shfl_xor(sd, 2); sd += __shfl_xor(sd, 4); sd += __shfl_xor(sd, 8);
        const float mn = fmaxf(m, sd), al = __expf(m - mn), pw = 3.f * __expf(sd - mn); m = mn; l = l * al + pw;
        a[0] = a[0] * al + pw * vs0[0]; a[1] = a[1] * al + pw * vs0[1]; a[2] = a[2] * al + pw * vs0[2]; a[3] = a[3] * al + pw * vs0[3];
        a[4] = a[4] * al + pw * vs1[0]; a[5] = a[5] * al + pw * vs1[1]; a[6] = a[6] * al + pw * vs1[2]; a[7] = a[7] * al + pw * vs1[3];
    }
    attn_merge_store(mg, t, part, lane, m, l, a, P0 + R * LD0 + 9216 + hd * 128, (bf16_t*)(p.ws + W_CAT0) + R * LDC0 + 2048 + hd * 128);
}

DI void smem_item(const Params& p, int item, int layer, LAS uchar* lds) {
    const int tid = otid(), w = tid >> 6, lane = tid & 63;
    const bf16_t* PX = (const bf16_t*)(p.ws + (layer ? W_P1 : W_P0)); const int ld = layer ? LD1 : LD0, qcol = layer ? 6144 : 10240, gcol = layer ? 6656 : 10752;
    bf16_t* CAT = (bf16_t*)(p.ws + (layer ? W_CAT1 : W_CAT0)); const int ldc = layer ? LDC1 : LDC0, ccol = layer ? 2048 : 3072;
    const int b = item >> 2, hd = item & 3, t = w & 3, part = w >> 2; const size_t R = TP + b * 4 + t;
    LAS float* q = (LAS float*)(lds + w * 512); LAS float* mg = (LAS float*)(lds + 4096);
    for (int dd = lane; dd < 128; dd += 64) q[dd] = bf2f(PX[R * ld + qcol + hd * 128 + dd]);
    __syncthreads();
    const float* kb = p.cmem_k + ((size_t)(layer * 32 + b) * 256 * 4 + hd) * 128; const float* vb = p.cmem_v + ((size_t)(layer * 32 + b) * 256 * 4 + hd) * 128;
    auto krow = [&](int j) { return kb + (size_t)j * 512; };
    auto vrow = [&](int j) { return vb + (size_t)j * 512; };
    float m = -1e30f, l = 0.f, a[8] = {0.f, 0.f, 0.f, 0.f, 0.f, 0.f, 0.f, 0.f};
    wave_attn(q, part * 128, part * 128 + 128, krow, vrow, lane, m, l, a);
    attn_merge_store(mg, t, part, lane, m, l, a, PX + R * ld + gcol + hd * 128, CAT + R * ldc + ccol + hd * 128);
}

DI void sret_item(const Params& p, int item, LAS uchar* lds) {
    const int tid = otid(), w = tid >> 6, lane = tid & 63;
    const bf16_t* P0 = (const bf16_t*)(p.ws + W_P0);
    const int b = item >> 3, hd = item & 7; const float lg = log1pf(-exp2f(-5.f - (float)hd));
    LAS float* qn = (LAS float*)lds; LAS float* kn = qn + 512; LAS float* sc = kn + 512; LAS float* gr = sc + 16; LAS float* red = gr + 48;
    const size_t R0 = TP + b * 4;
    { const int t = tid >> 7, d = tid & 127, pp = 2 * (d & 63) + (d >> 6);
        qn[t * 128 + d] = bf2f(P0[(R0 + t) * LD0 + hd * 128 + pp]); kn[t * 128 + d] = bf2f(P0[(R0 + t) * LD0 + 1024 + hd * 128 + pp]); }
    f32x4 v[4];
#pragma unroll
    for (int t = 0; t < 4; ++t) { const u32x2 r = *(const u32x2*)(P0 + (R0 + t) * LD0 + 2048 + hd * 256 + 4 * lane); v[t] = (f32x4){bf_lo(r[0]), bf_hi(r[0]), bf_lo(r[1]), bf_hi(r[1])}; }
    __syncthreads();
    if (tid < 16) { const int i = tid >> 2, j = tid & 3; float s = 0.f; for (int d = 0; d < 128; ++d) s += qn[i * 128 + d] * kn[j * 128 + d]; sc[tid] = j <= i ? s * __expf(lg * (float)(i - j)) : 0.f; }
    const float g1 = __expf(lg), g2 = g1 * g1, g3 = g2 * g1, g4 = g2 * g2;
    const float* sin_ = p.state_ret + ((size_t)(b * 8 + hd) * 128) * 256 + 4 * lane; float* sout = p.out + O_SSTATE + ((size_t)(b * 8 + hd) * 128) * 256 + 4 * lane;
    f32x4 cr[4]; for (int i = 0; i < 4; ++i) cr[i] = (f32x4){0.f, 0.f, 0.f, 0.f};
    const f32x4 kv0 = g3 * v[0], kv1 = g2 * v[1], kv2 = g1 * v[2], kv3 = v[3];
    f32x4 st[16];
#pragma unroll
    for (int dd = 0; dd < 16; ++dd) st[dd] = *(const f32x4*)(sin_ + (size_t)(16 * w + dd) * 256);
#pragma unroll
    for (int dd = 0; dd < 16; ++dd) { const int d = 16 * w + dd;
        cr[0] += qn[d] * st[dd]; cr[1] += qn[128 + d] * st[dd]; cr[2] += qn[256 + d] * st[dd]; cr[3] += qn[384 + d] * st[dd];
        *(f32x4*)(sout + (size_t)d * 256) = g4 * st[dd] + kn[d] * kv0 + kn[128 + d] * kv1 + kn[256 + d] * kv2 + kn[384 + d] * kv3; }
#pragma unroll
    for (int i = 0; i < 4; ++i) *(LAS f32x4*)(red + (w * 4 + i) * 256 + 4 * lane) = cr[i];
    __syncthreads();
    const int e = tid & 255; float o[4] = {0.f, 0.f, 0.f, 0.f};
    if (tid < 256) {
        float ve[4];
#pragma unroll
        for (int t = 0; t < 4; ++t) ve[t] = bf2f(P0[(R0 + t) * LD0 + 2048 + hd * 256 + e]);
        const float gp[4] = {g1, g2, g3, g4};
#pragma unroll
        for (int i = 0; i < 4; ++i) { float x = 0.f;
#pragma unroll
            for (int ww = 0; ww < 8; ++ww) x += red[(ww * 4 + i) * 256 + e];
            x *= gp[i];
#pragma unroll
            for (int j = 0; j < 4; ++j) if (j <= i) x += sc[i * 4 + j] * ve[j];
            o[i] = x; }
#pragma unroll
        for (int i = 0; i < 4; ++i) { const float aa = wave_sum(o[i]), bq = wave_sum(o[i] * o[i]); if (lane == 0) { gr[(w * 4 + i) * 2] = aa; gr[(w * 4 + i) * 2 + 1] = bq; } }
    }
    __syncthreads();
    if (tid < 256) {
        bf16_t* CAT0 = (bf16_t*)(p.ws + W_CAT0); const float gn = p.ret_gn[hd * 256 + e];
#pragma unroll
        for (int i = 0; i < 4; ++i) { float t1 = 0.f, t2 = 0.f; for (int ww = 0; ww < 4; ++ww) { t1 += gr[(ww * 4 + i) * 2]; t2 += gr[(ww * 4 + i) * 2 + 1]; }
            const float mu = t1 * (1.f / 256.f), var = t2 * (1.f / 256.f) - mu * mu, rstd = rsqrtf(fmaxf(var, 0.f) + 1e-6f);
            CAT0[(R0 + i) * LDC0 + hd * 256 + e] = f2bf((o[i] - mu) * rstd * gn * silu_f(bf2f(P0[(R0 + i) * LD0 + 4096 + hd * 256 + e]))); }
    }
    __syncthreads();
}

DI void sgate_item(const Params& p, int b) {
    const int tid = otid(); const int ch = tid * 4, g = ch >> 7;
    const bf16_t* P1 = (const bf16_t*)(p.ws + W_P1); const float* lns = (const float*)(p.ws + W_LNS); bf16_t* CAT1 = (bf16_t*)(p.ws + W_CAT1);
    const size_t R0 = TP + b * 4;
    const f32x4 gl = *(const f32x4*)(p.gmlp_ln + ch);
    f32x4 vn[4];
#pragma unroll
    for (int t = 0; t < 4; ++t) { const size_t R = R0 + t; const u32x2 raw = *(const u32x2*)(P1 + R * LD1 + 2048 + ch);
        const float mu = lns[2 * R] * (1.f / 2048.f), var = lns[2 * R + 1] * (1.f / 2048.f) - mu * mu, rstd = rsqrtf(fmaxf(var, 0.f) + 1e-6f);
        vn[t] = (f32x4){(bf_lo(raw[0]) - mu) * rstd * gl[0], (bf_hi(raw[0]) - mu) * rstd * gl[1], (bf_lo(raw[1]) - mu) * rstd * gl[2], (bf_hi(raw[1]) - mu) * rstd * gl[3]};
        *(f32x4*)(p.out + O_SGV + (size_t)(b * 4 + t) * 2048 + ch) = vn[t]; }
#pragma unroll
    for (int t = 0; t < 4; ++t) { const size_t R = R0 + t; const float bias = p.b_spatial[g * 128 + t]; f32x4 mixed = {bias, bias, bias, bias};
#pragma unroll
        for (int s = 0; s < 4; ++s) if (s <= t) mixed += p.w_spatial[(size_t)g * 16384 + t * 128 + s] * vn[s];
        const u32x2 ur = *(const u32x2*)(P1 + R * LD1 + ch), zr = *(const u32x2*)(P1 + R * LD1 + 4096 + ch);
        *(u32x2*)(CAT1 + R * LDC1 + ch) = (u32x2){pk_bf16(gelu_f(bf_lo(ur[0])) * mixed[0] * silu_f(bf_lo(zr[0])), gelu_f(bf_hi(ur[0])) * mixed[1] * silu_f(bf_hi(zr[0]))),
                                                  pk_bf16(gelu_f(bf_lo(ur[1])) * mixed[2] * silu_f(bf_lo(zr[1])), gelu_f(bf_hi(ur[1])) * mixed[3] * silu_f(bf_hi(zr[1])))}; }
}

DI void phase3(const Params& p) {
    int G = gridDim.x; asm volatile("" : "+s"(G));
    const int tid = otid(), B = blockIdx.x;
    const bf16_t* KVT = (const bf16_t*)(p.ws + W_KVT); bf16_t* STB = (bf16_t*)(p.ws + W_STB);
    for (int idx = B * 512 + tid; idx < 131072; idx += G * 512) {
        const int d2 = idx & 63, e = (idx >> 6) & 255, hd = idx >> 14;
        const float gd = __expf(128.f * log1pf(-exp2f(-5.f - (float)hd)));
        const size_t off = ((size_t)hd * 256 + e) * 128 + 2 * d2;
        float s0 = 0.f, s1 = 0.f;
#pragma unroll 16
        for (int c = 0; c < 64; ++c) { const unsigned kr = *(const unsigned*)(KVT + (size_t)c * 262144 + off); const f32x2 kv = {bf_lo(kr), bf_hi(kr)};
            *(unsigned*)(STB + (size_t)c * 262144 + off) = pk_bf16(s0, s1);
            s0 = gd * s0 + kv[0]; s1 = gd * s1 + kv[1]; }
        p.out[O_PSTATE + ((size_t)hd * 128 + d2) * 256 + e] = s0; p.out[O_PSTATE + ((size_t)hd * 128 + d2 + 64) * 256 + e] = s1;
    }
    const bf16_t* DO = (const bf16_t*)(p.ws + W_DILO); const float* DM = (const float*)(p.ws + W_DILM); const float* DL = (const float*)(p.ws + W_DILL);
    const bf16_t* P0 = (const bf16_t*)(p.ws + W_P0); bf16_t* CAT0 = (bf16_t*)(p.ws + W_CAT0);
#pragma unroll 2
    for (int idx = B * 512 + tid; idx < 8192 * 8 * 16; idx += G * 512) {
        const int c16 = idx & 15, hd = (idx >> 4) & 7; const size_t pos = idx >> 7;
        float mm[3], ll[3]; for (int b = 0; b < 3; ++b) { mm[b] = DM[((size_t)b * 8192 + pos) * 8 + hd]; ll[b] = DL[((size_t)b * 8192 + pos) * 8 + hd]; }
        const float M = fmaxf(mm[0], fmaxf(mm[1], mm[2])); float wt[3], den = 0.f; for (int b = 0; b < 3; ++b) { wt[b] = __expf(mm[b] - M) * ll[b]; den += wt[b]; }
        const float inv = 1.f / den; float acc[8] = {0.f, 0.f, 0.f, 0.f, 0.f, 0.f, 0.f, 0.f};
#pragma unroll
        for (int b = 0; b < 3; ++b) { const u32x4 o = *(const u32x4*)(DO + ((size_t)b * 8192 + pos) * 1024 + hd * 128 + c16 * 8); const float ww = wt[b] * inv;
#pragma unroll
            for (int q = 0; q < 4; ++q) { acc[2 * q] += ww * bf_lo(o[q]); acc[2 * q + 1] += ww * bf_hi(o[q]); } }
        const u32x4 gt = *(const u32x4*)(P0 + pos * LD0 + 9216 + hd * 128 + c16 * 8); u32x4 r;
#pragma unroll
        for (int q = 0; q < 4; ++q) r[q] = pk_bf16(acc[2 * q] * silu_f(bf_lo(gt[q])), acc[2 * q + 1] * silu_f(bf_hi(gt[q])));
        *(u32x4*)(CAT0 + pos * LDC0 + 2048 + hd * 128 + c16 * 8) = r;
    }
}

DI void load_o8(const bf16_t* os, int lane, f32x4 (&v)[8]) {
#pragma unroll
    for (int i = 0; i < 4; ++i) { const u32x4 r = *(const u32x4*)(os + (i * 64 + lane) * 8);
        v[2 * i] = (f32x4){bf_lo(r[0]), bf_hi(r[0]), bf_lo(r[1]), bf_hi(r[1])}; v[2 * i + 1] = (f32x4){bf_lo(r[2]), bf_hi(r[2]), bf_lo(r[3]), bf_hi(r[3])}; }
}
DI int o8_off(int i, int lane) { return ((i >> 1) * 64 + lane) * 8 + (i & 1) * 4; }
DI void phase6(const Params& p) {
    const int tid = otid(), wid = tid >> 6, lane = tid & 63, G = gridDim.x, B = blockIdx.x;
    const bf16_t* O = (const bf16_t*)(p.ws + W_O); bf16_t* XN1 = (bf16_t*)(p.ws + W_XN1);
    for (int row = B * 8 + wid; row < MPAD; row += G * 8) {
        bf16_t* dst = XN1 + (size_t)row * 2048;
        if (row >= NROW) { for (int i = 0; i < 8; ++i) *(u32x2*)(dst + (i * 64 + lane) * 4) = (u32x2){0u, 0u}; continue; }
        const float* xs = row < TP ? p.x_prompt + (size_t)row * 2048 : p.x_sample + (size_t)(row - TP) * 2048;
        float* hd = p.out + O_Y + (size_t)row * 2048;
        f32x4 v[8], x[8]; float ss = 0.f;
        load_o8(O + (size_t)row * 2048, lane, v);
#pragma unroll
        for (int i = 0; i < 8; ++i) x[i] = *(const f32x4*)(xs + o8_off(i, lane));
#pragma unroll
        for (int i = 0; i < 8; ++i) ss += v[i][0] * v[i][0] + v[i][1] * v[i][1] + v[i][2] * v[i][2] + v[i][3] * v[i][3];
        ss = wave_sum(ss); const float rs = rsqrtf(ss * (1.f / 2048.f) + 1e-6f); float s2 = 0.f;
#pragma unroll
        for (int i = 0; i < 8; ++i) { const f32x4 g = *(const f32x4*)(p.post_norm + o8_off(i, lane));
            v[i] = x[i] + v[i] * rs * g; *(f32x4*)(hd + o8_off(i, lane)) = v[i]; s2 += v[i][0] * v[i][0] + v[i][1] * v[i][1] + v[i][2] * v[i][2] + v[i][3] * v[i][3]; }
        s2 = wave_sum(s2); const float r2 = rsqrtf(s2 * (1.f / 2048.f) + 1e-6f);
#pragma unroll
        for (int i = 0; i < 4; ++i) { const f32x4 g0 = *(const f32x4*)(p.pre_norm + 2048 + o8_off(2 * i, lane)), g1 = *(const f32x4*)(p.pre_norm + 2048 + o8_off(2 * i + 1, lane));
            const f32x4 a = v[2 * i] * r2 * g0, b = v[2 * i + 1] * r2 * g1;
            *(u32x4*)(dst + (i * 64 + lane) * 8) = (u32x4){pk_bf16(a[0], a[1]), pk_bf16(a[2], a[3]), pk_bf16(b[0], b[1]), pk_bf16(b[2], b[3])}; }
    }
}

DI void phase10(const Params& p) {
    const int tid = otid(), wid = tid >> 6, lane = tid & 63, G = gridDim.x, B = blockIdx.x;
    const bf16_t* O = (const bf16_t*)(p.ws + W_O);
    for (int row = B * 8 + wid; row < NROW; row += G * 8) {
        float* hd = p.out + O_Y + (size_t)row * 2048;
        f32x4 v[8], x[8]; float ss = 0.f;
        load_o8(O + (size_t)row * 2048, lane, v);
#pragma unroll
        for (int i = 0; i < 8; ++i) x[i] = *(const f32x4*)(hd + o8_off(i, lane));
#pragma unroll
        for (int i = 0; i < 8; ++i) ss += v[i][0] * v[i][0] + v[i][1] * v[i][1] + v[i][2] * v[i][2] + v[i][3] * v[i][3];
        ss = wave_sum(ss); const float rs = rsqrtf(ss * (1.f / 2048.f) + 1e-6f);
#pragma unroll
        for (int i = 0; i < 8; ++i) { const f32x4 g = *(const f32x4*)(p.post_norm + 2048 + o8_off(i, lane));
            *(f32x4*)(hd + o8_off(i, lane)) = x[i] + v[i] * rs * g; }
    }
}

#ifndef REP_DIL
#define REP_DIL 1
#endif
#ifndef REP_RETA
#define REP_RETA 1
#endif
#ifndef REP_MEM
#define REP_MEM 1
#endif
#ifndef REP_SRET
#define REP_SRET 1
#endif
#ifndef REP_SDIL
#define REP_SDIL 1
#endif
#ifndef REP_P3
#define REP_P3 1
#endif
#ifndef REP_P4
#define REP_P4 1
#endif
#ifndef REP_P8
#define REP_P8 1
#endif
#ifndef REP_P0
#define REP_P0 1
#endif
#ifndef REP_G1
#define REP_G1 1
#endif
#ifndef REP_P2
#define REP_P2 1
#endif
__global__ void __launch_bounds__(512) mega_fwd(Params p) {
    extern __shared__ __attribute__((aligned(16))) uchar smem[];
    LAS uchar* lds = (LAS uchar*)smem;
    cg::grid_group grid = cg::this_grid();
    const int G = gridDim.x, B = blockIdx.x;
    uchar* ws = p.ws;
    if (otid() < 4) ((LAS unsigned*)(lds + LDS_BAR_OFF))[otid()] = 0u;
    __syncthreads();
    XcdBarrier xb = xcd_barrier_post((unsigned*)(ws + W_BAR), (volatile LAS unsigned*)(lds + LDS_BAR_OFF));
    if (p.out == nullptr) grid.sync();

    for (int rep = 0; rep < REP_P0; ++rep) phase0(p, lds);
    xcd_barrier(xb);
    {
        pg8::Gemm g{(const bf16_t*)(ws + W_A0), (const bf16_t*)(ws + W_WT1), MPAD, LD0, 2048};
        pg8::StaticOrder S; S.init(MPAD, LD0, G, B, 8);
        Epi1 E{(bf16_t*)(ws + W_P0), (bf16_t*)(ws + W_MEMKV), p.out, (const float*)(ws + W_TAC), (const float*)(ws + W_TAS), (const float*)(ws + W_TBC), (const float*)(ws + W_TBS), (bf16_t*)(ws + W_KFD), (bf16_t*)(ws + W_KFR), (bf16_t*)(ws + W_KFM)};
        { const int rem = 1460 % G;
          if (rem > 0) { if (B >= rem) wconv(p, lds, 2816, 5504, B - rem, G - rem); } else wconv(p, lds, 2816, 5504, B, G); }
        for (int rep = 0; rep < REP_G1; ++rep) pg8::gemm_phase(lds, g, S, E);
    }
    xcd_barrier(xb);
    for (int rep = 0; rep < REP_P2; ++rep)
    for (int it = B; it < 2048; it += G) {
        const int item = ((B & 1) && G == 256) ? ((it + 1280) & 2047) : it;
        if (item < 768) { for (int q = 0; q < REP_DIL; ++q) dil_tile(p, item, lds); }
        else if (item < 1280) { for (int q = 0; q < REP_RETA; ++q) reta_tile(p, item - 768, lds); }
        else if (item < 1408) { for (int q = 0; q < REP_MEM; ++q) memp_tile(p, item - 1280, 0, lds); }
        else if (item < 1664) { for (int q = 0; q < REP_SRET; ++q) sret_item(p, item - 1408, lds); }
        else if (item < 1920) { for (int q = 0; q < REP_SDIL; ++q) sdil_item(p, item - 1664, lds); }
        else { for (int q = 0; q < REP_MEM; ++q) smem_item(p, item - 1920, 0, lds); }
    }
    xcd_barrier(xb);
    for (int rep = 0; rep < REP_P3; ++rep) phase3(p);
    xcd_barrier(xb);
    for (int rep = 0; rep < REP_P4; ++rep)
    for (int item = B; item < 512; item += G) retc_tile(p, item, lds);
    xcd_barrier(xb);
    {
        pg8::Gemm g{(const bf16_t*)(ws + W_CAT0), (const bf16_t*)(ws + W_WT2), TP, 2048, LDC0};
        pg8::StaticOrder S; S.init(TP, 2048, G, B, 0);
        EpiO E{(bf16_t*)(ws + W_O)};
        pg8::gemm_phase(lds, g, S, E);
        mini_gemm<14>((const bf16_t*)(ws + W_CAT0) + (size_t)TP * LDC0, (const bf16_t*)(ws + W_WT2), nullptr, (bf16_t*)(ws + W_O) + (size_t)TP * 2048, lds);
    }
    xcd_barrier(xb);
    phase6(p);
    xcd_barrier(xb);
    {
        pg8::Gemm g{(const bf16_t*)(ws + W_XN1), (const bf16_t*)(ws + W_WT3), MPAD, LD1, 2048};
        pg8::StaticOrder S; S.init(MPAD, LD1, G, B, 0);
        Epi3 E{(bf16_t*)(ws + W_P1), (float*)(ws + W_LNS)};
        { const int rem = 924 % G;
          if (rem > 0) { if (B >= rem) wconv(p, lds, 5504, 6144, B - rem, G - rem); } else wconv(p, lds, 5504, 6144, B, G); }
        pg8::gemm_phase(lds, g, S, E);
    }
    xcd_barrier(xb);
    for (int rep = 0; rep < REP_P8; ++rep)
    for (int item = B; item < 800; item += G) {
        if (item < 512) gate_tile(p, item, lds);
        else if (item < 640) memp_tile(p, item - 512, 1, lds);
        else if (item < 768) smem_item(p, item - 640, 1, lds);
        else sgate_item(p, item - 768);
    }
    xcd_barrier(xb);
    {
        pg8::Gemm g{(const bf16_t*)(ws + W_CAT1), (const bf16_t*)(ws + W_WT4), TP, 2048, LDC1};
        pg8::StaticOrder S; S.init(TP, 2048, G, B, 0);
        EpiO E{(bf16_t*)(ws + W_O)};
        pg8::gemm_phase(lds, g, S, E);
        mini_gemm<10>((const bf16_t*)(ws + W_CAT1) + (size_t)TP * LDC1, (const bf16_t*)(ws + W_WT4), nullptr, (bf16_t*)(ws + W_O) + (size_t)TP * 2048, lds);
    }
    xcd_barrier(xb);
    phase10(p);
}

extern "C" void kernel_launch(void* const* d_in, const int* in_sizes, int n_in, void* d_out, int out_size, void* d_ws, size_t ws_size, hipStream_t stream) {
    static int grid_blocks = 0;
    if (!grid_blocks) {
        int dev = 0, cus = 0, per_cu = 0;
        hipGetDevice(&dev);
        hipDeviceGetAttribute(&cus, hipDeviceAttributeMultiprocessorCount, dev);
        hipFuncSetAttribute((const void*)mega_fwd, hipFuncAttributeMaxDynamicSharedMemorySize, LDS_BYTES);
        hipOccupancyMaxActiveBlocksPerMultiprocessor(&per_cu, (const void*)mega_fwd, 512, LDS_BYTES);
        if (per_cu < 1) { fprintf(stderr, "occupancy query returned %d\n", per_cu); per_cu = 1; }
        grid_blocks = cus;
        if (ws_size < W_END) fprintf(stderr, "workspace too small: %zu < %zu\n", ws_size, (size_t)W_END);
    }
    Params p{};
    const float** pp = (const float**)&p;
    for (int i = 0; i < 21; ++i) pp[i] = (const float*)d_in[i];
    p.out = (float*)d_out; p.ws = (uchar*)d_ws;
    (void)hipMemsetAsync((uchar*)d_ws + W_BAR, 0, (size_t)XCD_BAR_WORDS_C * 4, stream);
    void* args[] = {&p};
    hipError_t e = hipLaunchCooperativeKernel((const void*)mega_fwd, dim3(grid_blocks), dim3(512), args, LDS_BYTES, stream);
    if (e != hipSuccess) fprintf(stderr, "cooperative launch failed: %s (grid %d)\n", hipGetErrorString(e), grid_blocks);
}
```

```cpp
#include <hip/hip_runtime.h>
#include <hip/hip_cooperative_groups.h>
#include <cstdio>
namespace cg = cooperative_groups;

#define DI __device__ __forceinline__
#define LAS __attribute__((address_space(3)))
typedef unsigned short bf16_t;
typedef unsigned char uchar;
typedef short bf16x8 __attribute__((ext_vector_type(8)));
typedef short s16x4 __attribute__((ext_vector_type(4)));
typedef float f32x4 __attribute__((ext_vector_type(4)));
typedef float f32x2 __attribute__((ext_vector_type(2)));
typedef float f32x16 __attribute__((ext_vector_type(16)));
typedef unsigned u32x2 __attribute__((ext_vector_type(2)));
typedef unsigned u32x4 __attribute__((ext_vector_type(4)));
typedef __bf16 bfv2 __attribute__((ext_vector_type(2)));

#define MFMA32(a, b, c) __builtin_amdgcn_mfma_f32_32x32x16_bf16((a), (b), (c), 0, 0, 0)

constexpr int TP = 8192;
constexpr int NROW = 8320;
constexpr int MPAD = 8448;
constexpr int LD0 = 11264, LD1 = 7168, LDC0 = 3584, LDC1 = 2560;
constexpr float RSQ128 = 0.08838834764831845f;
constexpr int LDS_BYTES = 139264;
constexpr int XCD_BAR_WORDS_C = 3456;
constexpr int LDS_BAR_OFF = LDS_BYTES - 16;

constexpr size_t O_Y = 0, O_PSTATE = 17039360, O_PSWAK = 17301504, O_PSWAV = 19398656, O_PMEMK = 21495808,
                 O_PMEMV = 21757952, O_PGV = 22020096, O_SSTATE = 22282240, O_SSWAK = 30670848, O_SSWAV = 30801920, O_SGV = 30932992;

constexpr size_t al256(size_t x) { return (x + 255) & ~(size_t)255; }
constexpr size_t W_A0 = 0;
constexpr size_t W_WT1 = al256(W_A0 + (size_t)8960 * 2048 * 2);
constexpr size_t W_WT2 = al256(W_WT1 + (size_t)13312 * 2048 * 2);
constexpr size_t W_WT3 = al256(W_WT2 + (size_t)2048 * 3584 * 2);
constexpr size_t W_WT4 = al256(W_WT3 + (size_t)7168 * 2048 * 2);
constexpr size_t W_P0 = al256(W_WT4 + (size_t)2048 * 2560 * 2);
constexpr size_t W_MEMKV = al256(W_P0 + (size_t)MPAD * LD0 * 2);
constexpr size_t W_KVT = al256(W_MEMKV + (size_t)2 * 256 * 1024 * 2);
constexpr size_t W_STB = al256(W_KVT + (size_t)512 * 256 * 128 * 4);
constexpr size_t W_DILO = al256(W_STB + (size_t)512 * 256 * 128 * 2);
constexpr size_t W_DILM = al256(W_DILO + (size_t)3 * 8192 * 1024 * 2);
constexpr size_t W_DILL = al256(W_DILM + (size_t)3 * 8192 * 8 * 4);
constexpr size_t W_CAT0 = al256(W_DILL + (size_t)3 * 8192 * 8 * 4);
constexpr size_t W_O = al256(W_CAT0 + (size_t)MPAD * LDC0 * 2);
constexpr size_t W_XN1 = al256(W_O + (size_t)MPAD * 2048 * 4);
constexpr size_t W_P1 = al256(W_XN1 + (size_t)MPAD * 2048 * 2);
constexpr size_t W_LNS = al256(W_P1 + (size_t)MPAD * LD1 * 2);
constexpr size_t W_CAT1 = al256(W_LNS + (size_t)MPAD * 2 * 4);
constexpr size_t W_TAC = al256(W_CAT1 + (size_t)MPAD * LDC1 * 2);
constexpr size_t W_TAS = al256(W_TAC + (size_t)MPAD * 64 * 4);
constexpr size_t W_TBC = al256(W_TAS + (size_t)MPAD * 64 * 4);
constexpr size_t W_TBS = al256(W_TBC + (size_t)MPAD * 16 * 4);
constexpr size_t W_WC = al256(W_TBS + (size_t)MPAD * 16 * 4);
constexpr size_t W_KFD = al256(W_WC + (size_t)16 * 128 * 128 * 2);
constexpr size_t W_KFR = al256(W_KFD + (size_t)3 * 8192 * 1024 * 2);
constexpr size_t W_KFM = al256(W_KFR + (size_t)8192 * 1024 * 2);
constexpr size_t W_BAR = al256(W_KFM + (size_t)2 * 256 * 512 * 2);
constexpr size_t W_END = al256(W_BAR + (size_t)XCD_BAR_WORDS_C * 4);

struct Params {
    const float *x_prompt, *x_sample, *state_ret, *cache_k, *cache_v, *cmem_k, *cmem_v, *mem_prompt, *pre_norm, *post_norm, *mem_norm,
        *w_mem_k, *w_mem_v, *w_in_even, *ret_gn, *w_out_even, *w_in_odd, *gmlp_ln, *w_spatial, *b_spatial, *w_out_odd;
    float* out;
    uchar* ws;
};

DI int otid() { int t = __builtin_amdgcn_workitem_id_x(); asm volatile("" : "+v"(t)); return t; }
DI unsigned pk_bf16(float lo, float hi) { f32x2 v = {lo, hi}; bfv2 b = __builtin_convertvector(v, bfv2); return __builtin_bit_cast(unsigned, b); }
DI bf16_t f2bf(float x) { return (bf16_t)(pk_bf16(x, 0.f) & 0xffffu); }
DI float bf_lo(unsigned u) { return __uint_as_float(u << 16); }
DI float bf_hi(unsigned u) { return __uint_as_float(u & 0xffff0000u); }
DI float bf2f(bf16_t b) { return __uint_as_float(((unsigned)b) << 16); }
DI float wave_sum(float v) { for (int o = 32; o > 0; o >>= 1) v += __shfl_xor(v, o); return v; }
DI float wave_max(float v) { for (int o = 32; o > 0; o >>= 1) v = fmaxf(v, __shfl_xor(v, o)); return v; }
DI float silu_f(float x) { return x * __builtin_amdgcn_rcpf(1.f + __expf(-x)); }
DI float gelu_f(float x) { const float a = fmaf(x * x, -0.10294324f, -2.3022082f); return x * __builtin_amdgcn_rcpf(1.f + __builtin_amdgcn_exp2f(a * x)); }
DI int crow(int i, int h) { return (i & 3) + 8 * (i >> 2) + 4 * h; }
DI bf16x8 pack8(float a, float b, float c, float d, float e, float f, float g, float h) {
    u32x4 p = {pk_bf16(a, b), pk_bf16(c, d), pk_bf16(e, f), pk_bf16(g, h)}; return __builtin_bit_cast(bf16x8, p); }
DI s16x4 trr(LAS uchar* a) { return __builtin_amdgcn_ds_read_tr16_b64_v4i16((LAS s16x4*)a); }
DI bf16x8 tr_frag(LAS uchar* base, int RS, int krow_lo, int krow_hi, int col0, int lane) {
    const int i16 = lane & 15, q = i16 >> 2, pq = i16 & 3, blk = (lane >> 4) & 1;
    const int cb = (col0 + 16 * blk) * 2 + 8 * pq;
    s16x4 lo = trr(base + (krow_lo + q) * RS + cb);
    s16x4 hi = trr(base + (krow_hi + q) * RS + cb);
    return __builtin_shufflevector(lo, hi, 0, 1, 2, 3, 4, 5, 6, 7);
}

#define XB_TMO      128
#define XB_XCNT(j)  (256  + 64 * (j))
#define XB_XSUB(j)  (1280 + 64 * (j))
#define XB_XGEN(j)  (2304 + 64 * (j))
#define XB_TOP      3328
#define XB_TOPGEN   3392
#define XCD_BAR_WORDS 3456
#define XB_SPIN_CAP (1u << 22)
DI unsigned xb_ld(unsigned* p) { return __hip_atomic_load(p, __ATOMIC_RELAXED, __HIP_MEMORY_SCOPE_AGENT); }
DI unsigned xb_add(unsigned* p, unsigned v) { return __hip_atomic_fetch_add(p, v, __ATOMIC_RELAXED, __HIP_MEMORY_SCOPE_AGENT); }
DI unsigned xb_xcc_id() { return (unsigned)__builtin_amdgcn_s_getreg((3 << 11) | 20) & 0xFu; }
#define XB_SPIN(cond, bar) do { unsigned _sp = 0; while (cond) { __builtin_amdgcn_s_sleep(1); \
    if ((++_sp & 255u) == 0u) { if (xb_ld(&(bar)[XB_TMO])) break; if (_sp > XB_SPIN_CAP) { atomicAdd(&(bar)[XB_TMO], 1u); break; } } } } while (0)
struct XcdBarrier { unsigned* bar; unsigned x; volatile LAS unsigned* st; };
DI XcdBarrier xcd_barrier_post(unsigned* bar, volatile LAS unsigned* st) {
    XcdBarrier b; b.bar = bar; b.x = xb_xcc_id(); b.st = st;
    if (otid() == 0) (void)xb_add(&bar[XB_XCNT(b.x)], 1u);
    return b;
}
DI void xcd_barrier_complete(unsigned* bar, unsigned x, unsigned& nloc, unsigned& nx) {
    const unsigned G = gridDim.x;
    unsigned sum, cnt, mine, sp = 0u;
    for (;;) {
        sum = 0u; cnt = 0u; mine = 0u;
#pragma unroll
        for (unsigned j = 0; j < 16; ++j) { const unsigned c = xb_ld(&bar[XB_XCNT(j)]); sum += c; cnt += (c > 0u) ? 1u : 0u; mine = (j == x) ? c : mine; }
        if (sum == G) break;
        __builtin_amdgcn_s_sleep(1);
        if ((++sp & 255u) == 0u) { if (xb_ld(&bar[XB_TMO])) break; if (sp > XB_SPIN_CAP) { atomicAdd(&bar[XB_TMO], 1u); break; } }
    }
    nloc = mine > 0u ? mine : 1u; nx = cnt > 0u ? cnt : 1u;
}
DI void xcd_barrier(const XcdBarrier& b) {
    asm volatile("s_waitcnt vmcnt(0)" ::: "memory");
    __syncthreads();
    if (otid() == 0) {
        unsigned* bar = b.bar;
        const unsigned bx = xb_xcc_id();
        __builtin_amdgcn_s_waitcnt(0);
        unsigned nloc = b.st[0], nx = b.st[1];
        if (nloc == 0u) { xcd_barrier_complete(bar, bx, nloc, nx); b.st[0] = nloc; b.st[1] = nx; }
        const unsigned old = xb_add(&bar[XB_XSUB(bx)], 1u);
        const unsigned gen = old / nloc;
        if (old + 1u == (gen + 1u) * nloc) {
            __builtin_amdgcn_fence(__ATOMIC_RELEASE, "agent");
            asm volatile("s_waitcnt vmcnt(0)" ::: "memory");
            const unsigned og = xb_add(&bar[XB_TOP], 1u);
            const unsigned tg = og / nx;
            if (og + 1u == (tg + 1u) * nx) xb_add(&bar[XB_TOPGEN], 1u);
            else XB_SPIN(xb_ld(&bar[XB_TOPGEN]) == tg, bar);
            __builtin_amdgcn_fence(__ATOMIC_ACQUIRE, "agent");
            xb_add(&bar[XB_XGEN(bx)], 1u);
            asm volatile("s_waitcnt vmcnt(0)" ::: "memory");
        } else {
            XB_SPIN(xb_ld(&bar[XB_XGEN(bx)]) == gen, bar);
            __builtin_amdgcn_fence(__ATOMIC_ACQUIRE, "agent");
            asm volatile("s_waitcnt vmcnt(0)" ::: "memory");
        }
    }
    __syncthreads();
}

namespace pg8 {
constexpr int BM = 256, BK = 64, HALF = 128, HTB = HALF * BK * 2, NXCD = 8, WGM = 8;
DI int lds_byte(int r, int c) { const int st = (r >> 4) * 2 + (c >> 5), rr = r & 15, cc = c & 31, ob = rr * 64 + cc * 2; return st * 1024 + (ob ^ (((ob >> 9) & 1) << 5)); }
DI void stage_rc(int b, int& R, int& C) { const int st = b / 1024, sb = b % 1024, swz = sb ^ (((sb >> 9) & 1) << 5); R = (st >> 1) * 16 + swz / 64; C = (st & 1) * 32 + (swz % 64) / 2; }
DI int perm32(int rho) { const int n = rho >> 4, i = rho & 15; return 8 * (i >> 2) + 4 * n + (i & 3); }
struct Unit { int pm, pn; };
struct Gemm { const bf16_t* A; const bf16_t* Bt; int M, N, K; };
struct StaticOrder {
    int nM, nN, nwg, G, c, extra;
    DI void init(int M, int N, int G_, int c_, int extra_) { nM = M / BM; nN = N / BM; nwg = nM * nN; G = G_; c = c_; extra = extra_; }
    DI bool next(int i, Unit& u) const {
        const long L = (long)i * G + c; if (L >= nwg + extra) return false;
        if (L >= nwg) { const int q = (int)(L - nwg); u.pm = nM + (q >> 2); u.pn = nN + q; return true; }
        int wgid = (int)L; { const int q = nwg / NXCD, r = nwg % NXCD, xcd = wgid % NXCD, off = wgid / NXCD; wgid = (xcd < r ? xcd * (q + 1) : r * (q + 1) + (xcd - r) * q) + off; }
        const int nig = WGM * nN, gid = wgid / nig, fm = gid * WGM, gsz = (nM - fm) < WGM ? (nM - fm) : WGM;
        u.pm = fm + ((wgid % nig) % gsz); u.pn = (wgid % nig) / gsz; return true;
    }
};

template <class Epi>
DI void gemm_phase(LAS uchar* lds, const Gemm g, const StaticOrder& S, const Epi& E) {
    const int tid = otid(), wid = __builtin_amdgcn_readfirstlane(tid >> 6), lane = tid & 63, wr = wid >> 2, wc = wid & 3, fr = lane & 15, fq = lane >> 4;
    const int K = g.K, nt = K / BK;
    unsigned voffA[2], voffB[2];
#pragma unroll
    for (int i = 0; i < 2; ++i) { int R, C; stage_rc(tid * 16 + i * 8192, R, C); const int Rb = Epi::PERM ? ((R & ~31) + perm32(R & 31)) : R;
        voffA[i] = (unsigned)(R * K + C) * 2u; voffB[i] = (unsigned)(Rb * K + C) * 2u; }
    const size_t kstep = (size_t)(BK * 2);
    const size_t hstep = (size_t)HALF * K * 2;
    const size_t tstep = 2 * hstep;
    const unsigned ldsw = (unsigned)wid * 1024u;
    const int aoff = lds_byte(wr * 64 + fr, fq * 8), boff = lds_byte(wc * 32 + fr, fq * 8);
#define PG8_SA(b, h) (((b) * 2 + (h)) * HTB)
#define PG8_SB(b, h) ((4 + (b) * 2 + (h)) * HTB)
#define PG8_STAGE(bufoff, gbase, voff) do { _Pragma("unroll") for (int _i = 0; _i < 2; ++_i) \
        __builtin_amdgcn_global_load_lds((const unsigned*)((const char*)(gbase) + (voff)[_i]), (LAS unsigned*)(lds + (bufoff) + ldsw + _i * 8192), 16, 0, 0); } while (0)
#define PG8_LDA(dst, b, h) do { _Pragma("unroll") for (int m = 0; m < 4; ++m) _Pragma("unroll") for (int k = 0; k < 2; ++k) dst[m][k] = *(const LAS bf16x8*)(lds + PG8_SA(b, h) + aoff + m * 2048 + k * 1024); } while (0)
#define PG8_LDB(dst, b, h) do { _Pragma("unroll") for (int n = 0; n < 2; ++n) _Pragma("unroll") for (int k = 0; k < 2; ++k) dst[n][k] = *(const LAS bf16x8*)(lds + PG8_SB(b, h) + boff + n * 2048 + k * 1024); } while (0)
#define PG8_MMA(ai, bj, At, Bt) do { __builtin_amdgcn_s_setprio(1); _Pragma("unroll") for (int m = 0; m < 4; ++m) _Pragma("unroll") for (int n = 0; n < 2; ++n) _Pragma("unroll") for (int k = 0; k < 2; ++k) \
        acc[ai][bj][m][n] = __builtin_amdgcn_mfma_f32_16x16x32_bf16(Bt[n][k], At[m][k], acc[ai][bj][m][n], 0, 0, 0); __builtin_amdgcn_s_setprio(0); } while (0)
#define PG8_WAIT_V(n) asm volatile("s_waitcnt vmcnt(" #n ")" ::: "memory")
#define PG8_WAIT_L(n) asm volatile("s_waitcnt lgkmcnt(" #n ")" ::: "memory")
#define PG8_BAR __builtin_amdgcn_s_barrier()
#define PG8_SCHED __builtin_amdgcn_sched_barrier(0)
    Unit cur, nxt; int ui = 0;
    if (!S.next(0, cur)) return;
    f32x4 acc[2][2][4][2];
#pragma unroll
    for (int a = 0; a < 2; ++a)
#pragma unroll
        for (int b = 0; b < 2; ++b)
#pragma unroll
            for (int m = 0; m < 4; ++m)
#pragma unroll
                for (int n = 0; n < 2; ++n) acc[a][b][m][n] = (f32x4){0.f, 0.f, 0.f, 0.f};
    bf16x8 At[4][2], B0[2][2], B1[2][2];
    const char* cA = (const char*)g.A + (size_t)cur.pm * tstep; const char* cB = (const char*)g.Bt + (size_t)cur.pn * tstep;
    PG8_STAGE(PG8_SB(0, 0), cB, voffB); PG8_STAGE(PG8_SA(0, 0), cA, voffA); PG8_STAGE(PG8_SB(0, 1), cB + hstep, voffB); PG8_STAGE(PG8_SA(0, 1), cA + hstep, voffA);
    if (wr == 1) PG8_BAR;
    PG8_WAIT_V(4); PG8_BAR;
    PG8_STAGE(PG8_SB(1, 0), cB + kstep, voffB); PG8_STAGE(PG8_SA(1, 0), cA + kstep, voffA); PG8_STAGE(PG8_SB(1, 1), cB + hstep + kstep, voffB);
    PG8_WAIT_V(6); PG8_BAR;
    for (;;) {
        const bool has_next = S.next(ui + 1, nxt);
        const char* nA = has_next ? (const char*)g.A + (size_t)nxt.pm * tstep : cA; const char* nB = has_next ? (const char*)g.Bt + (size_t)nxt.pn * tstep : cB;
        for (int t = 0; t < nt; t += 2) {
            const bool last = (t == nt - 2);
            const char* a1 = cA + (size_t)(t + 1) * kstep;
            const char* a2 = last ? nA : cA + (size_t)(t + 2) * kstep; const char* b2 = last ? nB : cB + (size_t)(t + 2) * kstep;
            const char* a3 = a2 + kstep; const char* b3 = b2 + kstep;
            PG8_LDB(B0, 0, 0); PG8_SCHED; PG8_LDA(At, 0, 0); PG8_STAGE(PG8_SA(1, 1), a1 + hstep, voffA);
            PG8_WAIT_L(8); PG8_BAR; PG8_WAIT_L(0); PG8_MMA(0, 0, At, B0); PG8_BAR; PG8_SCHED;
            PG8_LDB(B1, 0, 1); PG8_STAGE(PG8_SB(0, 0), b2, voffB);
            PG8_BAR; PG8_WAIT_L(0); PG8_MMA(0, 1, At, B1); PG8_BAR;
            PG8_LDA(At, 0, 1); PG8_STAGE(PG8_SA(0, 0), a2, voffA);
            PG8_BAR; PG8_WAIT_L(0); PG8_MMA(1, 0, At, B0); PG8_BAR; PG8_SCHED;
            PG8_STAGE(PG8_SB(0, 1), b2 + hstep, voffB);
            PG8_WAIT_V(6); PG8_BAR; PG8_MMA(1, 1, At, B1); PG8_BAR;
            PG8_LDB(B0, 1, 0); PG8_SCHED; PG8_LDA(At, 1, 0); PG8_STAGE(PG8_SA(0, 1), a2 + hstep, voffA);
            PG8_WAIT_L(8); PG8_BAR; PG8_WAIT_L(0); PG8_MMA(0, 0, At, B0); PG8_BAR; PG8_SCHED;
            PG8_LDB(B1, 1, 1); PG8_STAGE(PG8_SB(1, 0), b3, voffB);
            PG8_BAR; PG8_WAIT_L(0); PG8_MMA(0, 1, At, B1); PG8_BAR;
            PG8_LDA(At, 1, 1); PG8_STAGE(PG8_SA(1, 0), a3, voffA);
            PG8_BAR; PG8_WAIT_L(0); PG8_MMA(1, 0, At, B0); PG8_BAR; PG8_SCHED;
            PG8_STAGE(PG8_SB(1, 1), b3 + hstep, voffB);
            PG8_WAIT_V(6); PG8_BAR; PG8_MMA(1, 1, At, B1); PG8_BAR;
        }
        E(acc, cur, wr, wc, fr, fq);
        if (!has_next) break;
#pragma unroll
        for (int a = 0; a < 2; ++a)
#pragma unroll
            for (int b = 0; b < 2; ++b)
#pragma unroll
                for (int m = 0; m < 4; ++m)
#pragma unroll
                    for (int n = 0; n < 2; ++n) acc[a][b][m][n] = (f32x4){0.f, 0.f, 0.f, 0.f};
        cur = nxt; cA = nA; cB = nB; ++ui;
    }
    PG8_WAIT_V(0);
    if (wr == 0) PG8_BAR;
    PG8_BAR;
#undef PG8_SA
#undef PG8_SB
#undef PG8_STAGE
#undef PG8_LDA
#undef PG8_LDB
#undef PG8_MMA
#undef PG8_WAIT_V
#undef PG8_WAIT_L
#undef PG8_BAR
#undef PG8_SCHED
}
}
using pg8::Unit;

struct EpiF32 {
    static constexpr bool PERM = false;
    float* C; int ldc;
    DI void operator()(const f32x4 (&acc)[2][2][4][2], const Unit& u, int wr, int wc, int fr, int fq) const {
        const int row0 = u.pm * 256 + wr * 64 + fr, col0 = u.pn * 256 + wc * 32 + 4 * fq;
#pragma unroll
        for (int ai = 0; ai < 2; ++ai)
#pragma unroll
            for (int m = 0; m < 4; ++m) { float* rowp = C + (size_t)(row0 + ai * 128 + m * 16) * ldc + col0;
#pragma unroll
                for (int bj = 0; bj < 2; ++bj)
#pragma unroll
                    for (int n = 0; n < 2; ++n) *(f32x4*)(rowp + bj * 128 + n * 16) = acc[ai][bj][m][n]; }
    }
};

struct EpiO {
    static constexpr bool PERM = true;
    bf16_t* C;
    DI void operator()(const f32x4 (&acc)[2][2][4][2], const Unit& u, int wr, int wc, int fr, int fq) const {
        asm volatile("" : "+v"(fr), "+v"(fq));
        const int row0 = u.pm * 256 + wr * 64 + fr, col0 = u.pn * 256 + wc * 32 + 8 * fq;
#pragma unroll
        for (int ai = 0; ai < 2; ++ai)
#pragma unroll
            for (int m = 0; m < 4; ++m) { bf16_t* rowp = C + (size_t)(row0 + ai * 128 + m * 16) * 2048 + col0;
#pragma unroll
                for (int bj = 0; bj < 2; ++bj) { const f32x4 v0 = acc[ai][bj][m][0], v1 = acc[ai][bj][m][1];
                    *(u32x4*)(rowp + bj * 128) = (u32x4){pk_bf16(v0[0], v0[1]), pk_bf16(v0[2], v0[3]), pk_bf16(v1[0], v1[1]), pk_bf16(v1[2], v1[3])}; } }
    }
};

struct Epi1 {
    static constexpr bool PERM = true;
    bf16_t* P0; bf16_t* memkv; float* out; const float *tAc, *tAs, *tBc, *tBs; bf16_t *kfd, *kfr, *kfm;
    template <int TYPE>
    DI void body(const f32x4 (&acc)[2][2][4][2], const Unit& u, int wr, int wc, int fr, int fq) const {
        const int hp0 = wc * 32 + fq * 8;
#pragma unroll
        for (int ai = 0; ai < 2; ++ai)
#pragma unroll
            for (int m = 0; m < 4; ++m) {
                const int r = u.pm * 256 + ai * 128 + wr * 64 + m * 16 + fr;
                f32x4 cs = {1.f, 1.f, 1.f, 1.f}, sn = {0.f, 0.f, 0.f, 0.f};
                bool rot = false;
                if (TYPE == 0 || TYPE == 1) { cs = *(const f32x4*)(tAc + (size_t)r * 64 + (hp0 >> 1)); sn = *(const f32x4*)(tAs + (size_t)r * 64 + (hp0 >> 1)); rot = true; }
                if ((TYPE == 4 || TYPE == 5) && wc == 0) { cs = *(const f32x4*)(tBc + (size_t)r * 16 + (hp0 >> 1)); sn = *(const f32x4*)(tBs + (size_t)r * 16 + (hp0 >> 1)); rot = true; }
#pragma unroll
                for (int bj = 0; bj < 2; ++bj) {
                    f32x4 v0 = acc[ai][bj][m][0], v1 = acc[ai][bj][m][1];
                    if (TYPE == 0 || TYPE == 1 || TYPE == 4 || TYPE == 5) {
                        if (rot) {
                            f32x4 o0 = {v0[0] * cs[0] - v0[1] * sn[0], v0[1] * cs[0] + v0[0] * sn[0], v0[2] * cs[1] - v0[3] * sn[1], v0[3] * cs[1] + v0[2] * sn[1]};
                            f32x4 o1 = {v1[0] * cs[2] - v1[1] * sn[2], v1[1] * cs[2] + v1[0] * sn[2], v1[2] * cs[3] - v1[3] * sn[3], v1[3] * cs[3] + v1[2] * sn[3]};
                            v0 = o0; v1 = o1;
                        }
                        if (TYPE == 1 || TYPE == 4) { v0 *= RSQ128; v1 *= RSQ128; }
                    }
                    if (TYPE == 3) { for (int j = 0; j < 4; ++j) { v0[j] = silu_f(v0[j]); v1[j] = silu_f(v1[j]); } }
                    if (TYPE == 7) { v0 *= RSQ128; v1 *= RSQ128; }
                    u32x4 w = {pk_bf16(v0[0], v0[1]), pk_bf16(v0[2], v0[3]), pk_bf16(v1[0], v1[1]), pk_bf16(v1[2], v1[3])};
                    *(u32x4*)(P0 + (size_t)r * LD0 + u.pn * 256 + bj * 128 + hp0) = w;
                    if ((TYPE == 1 || TYPE == 5) && r < TP) {
                        const unsigned kh = (unsigned)((hp0 >> 4) * 512 + ((hp0 >> 3) & 1) * 256);
                        if (TYPE == 1) { const unsigned hd = (unsigned)((u.pn - 4) * 2 + bj);
                            *(u32x4*)(kfr + (hd * 1048576u + (unsigned)(r >> 5) * 4096u + kh + (unsigned)(r & 31) * 8u)) = w; }
                        else { const unsigned hd = (unsigned)((u.pn - 28) * 2 + bj);
#pragma unroll
                            for (int b = 0; b < 3; ++b) { const int sh = 2 * b; const unsigned L = (unsigned)r >> sh, res = (unsigned)r & ((1u << sh) - 1u);
                                *(u32x4*)(kfd + ((unsigned)b * 8388608u + hd * 1048576u + (res * (256u >> sh) + (L >> 5)) * 4096u + kh + (L & 31u) * 8u)) = w; } }
                    }
                    if (TYPE == 5 || TYPE == 6) {
                        float* dstrow = nullptr;
                        if (r >= 6144 && r < 8192) dstrow = out + (TYPE == 5 ? O_PSWAK : O_PSWAV) + (size_t)(r - 6144) * 1024;
                        else if (r >= 8192 && r < NROW) dstrow = out + (TYPE == 5 ? O_SSWAK : O_SSWAV) + (size_t)(r - 8192) * 1024;
                        if (dstrow) {
                            const int hd = (u.pn - (TYPE == 5 ? 28 : 32)) * 2 + bj; float* d = dstrow + hd * 128;
                            if (TYPE == 5 && wc == 0) { const int i0 = hp0 >> 1;
                                *(f32x4*)(d + i0) = (f32x4){v0[0], v0[2], v1[0], v1[2]}; *(f32x4*)(d + 16 + i0) = (f32x4){v0[1], v0[3], v1[1], v1[3]}; }
                            else { *(f32x4*)(d + hp0) = v0; *(f32x4*)(d + hp0 + 4) = v1; }
                        }
                    }
                }
                if (TYPE == 1 || TYPE == 5) asm volatile("" ::: "memory");
            }
    }
    DI void operator()(const f32x4 (&acc)[2][2][4][2], const Unit& u, int wr, int wc, int fr, int fq) const {
        asm volatile("" : "+v"(fr), "+v"(fq));
        if (u.pm >= 33) {
            const int layer = u.pm - 33, cn0 = (u.pn - 44 - 4 * layer) * 256, hp0 = wc * 32 + fq * 8;
#pragma unroll
            for (int ai = 0; ai < 2; ++ai)
#pragma unroll
                for (int m = 0; m < 4; ++m) { const int rl = ai * 128 + wr * 64 + m * 16 + fr;
#pragma unroll
                    for (int bj = 0; bj < 2; ++bj) { const f32x4 v0 = acc[ai][bj][m][0], v1 = acc[ai][bj][m][1]; const int col = cn0 + bj * 128 + hp0;
                        u32x4 w = {pk_bf16(v0[0], v0[1]), pk_bf16(v0[2], v0[3]), pk_bf16(v1[0], v1[1]), pk_bf16(v1[2], v1[3])};
                        *(u32x4*)(memkv + (size_t)(layer * 256 + rl) * 1024 + col) = w;
                        if (col < 512) { const int hd = col >> 7, hq = col & 127, ks = hq >> 4, hl = (hq >> 3) & 1;
                            *(u32x4*)(kfm + ((((size_t)(layer * 4 + hd) * 8 + (rl >> 5)) * 8 + ks) * 64 + hl * 32 + (rl & 31)) * 8) = w; }
                        float* d = out + (col < 512 ? O_PMEMK : O_PMEMV) + (size_t)(layer * 256 + rl) * 512 + (col & 511);
                        *(f32x4*)d = v0; *(f32x4*)(d + 4) = v1; } }
            return;
        }
        const int pn = u.pn;
        if (pn < 4) body<0>(acc, u, wr, wc, fr, fq); else if (pn < 8) body<1>(acc, u, wr, wc, fr, fq); else if (pn < 16) body<2>(acc, u, wr, wc, fr, fq);
        else if (pn < 24) body<3>(acc, u, wr, wc, fr, fq); else if (pn < 28) body<4>(acc, u, wr, wc, fr, fq); else if (pn < 32) body<5>(acc, u, wr, wc, fr, fq);
        else if (pn < 36) body<6>(acc, u, wr, wc, fr, fq); else if (pn < 40) body<3>(acc, u, wr, wc, fr, fq); else if (pn < 42) body<7>(acc, u, wr, wc, fr, fq);
        else body<3>(acc, u, wr, wc, fr, fq);
    }
};

struct Epi3 {
    static constexpr bool PERM = true;
    bf16_t* P1; float* lns;
    template <int TYPE>
    DI void body(const f32x4 (&acc)[2][2][4][2], const Unit& u, int wr, int wc, int fr, int fq) const {
        const int hp0 = wc * 32 + fq * 8;
#pragma unroll
        for (int ai = 0; ai < 2; ++ai)
#pragma unroll
            for (int m = 0; m < 4; ++m) {
                const int r = u.pm * 256 + ai * 128 + wr * 64 + m * 16 + fr;
                float s1 = 0.f, s2 = 0.f;
#pragma unroll
                for (int bj = 0; bj < 2; ++bj) {
                    f32x4 v0 = acc[ai][bj][m][0], v1 = acc[ai][bj][m][1];
#pragma unroll
                    for (int j = 0; j < 4; ++j) {
                        if (TYPE <= 1) { v0[j] = gelu_f(v0[j]); v1[j] = gelu_f(v1[j]); }
                        if (TYPE == 2) { v0[j] = silu_f(v0[j]); v1[j] = silu_f(v1[j]); }
                        if (TYPE == 3) { v0[j] *= RSQ128; v1[j] *= RSQ128; }
                        if (TYPE == 1) { s1 += v0[j] + v1[j]; s2 += v0[j] * v0[j] + v1[j] * v1[j]; }
                    }
                    u32x4 w = {pk_bf16(v0[0], v0[1]), pk_bf16(v0[2], v0[3]), pk_bf16(v1[0], v1[1]), pk_bf16(v1[2], v1[3])};
                    *(u32x4*)(P1 + (size_t)r * LD1 + u.pn * 256 + bj * 128 + hp0) = w;
                }
                if (TYPE == 1) {
                    s1 += __shfl_xor(s1, 16); s2 += __shfl_xor(s2, 16); s1 += __shfl_xor(s1, 32); s2 += __shfl_xor(s2, 32);
                    if (fq == 0) { atomicAdd(lns + 2 * r, s1); atomicAdd(lns + 2 * r + 1, s2); }
                }
            }
    }
    DI void operator()(const f32x4 (&acc)[2][2][4][2], const Unit& u, int wr, int wc, int fr, int fq) const {
        asm volatile("" : "+v"(fr), "+v"(fq));
        const int pn = u.pn;
        if (pn < 8) body<0>(acc, u, wr, wc, fr, fq); else if (pn < 16) body<1>(acc, u, wr, wc, fr, fq); else if (pn < 24) body<2>(acc, u, wr, wc, fr, fq);
        else if (pn < 26) body<3>(acc, u, wr, wc, fr, fq); else body<2>(acc, u, wr, wc, fr, fq);
    }
};

DI int orig_col(int p, int mode) {
    if (mode == 1) {
        const int hp = p & 127, base = p & ~127;
        if (p < 2048) return base + (hp >> 1) + 64 * (hp & 1);
        if (p >= 6144 && p < 8192 && hp < 32) return base + (hp >> 1) + 16 * (hp & 1);
    }
    return p;
}

DI void wconv(const Params& p, LAS uchar* lds, int t_begin, int t_end, int start, int stride) {
    const int tid = otid();
    bf16_t* WT1 = (bf16_t*)(p.ws + W_WT1);
    LAS float* tl = (LAS float*)lds;
    {
        struct WT { const float* src; bf16_t* dst; int K, N, mode, kt, pt; };
        auto decode = [&](int t) { WT r; int tt = t; r.mode = 0;
            if (tt < 2816) { r.src = p.w_in_even; r.dst = WT1; r.K = 2048; r.N = 11264; r.mode = 1; }
            else if ((tt -= 2816) < 896) { r.src = p.w_out_even; r.dst = (bf16_t*)(p.ws + W_WT2); r.K = 3584; r.N = 2048; }
            else if ((tt -= 896) < 1792) { r.src = p.w_in_odd; r.dst = (bf16_t*)(p.ws + W_WT3); r.K = 2048; r.N = 7168; }
            else if ((tt -= 1792) < 640) { r.src = p.w_out_odd; r.dst = (bf16_t*)(p.ws + W_WT4); r.K = 2560; r.N = 2048; }
            else { tt -= 640; const int which = tt >> 7; tt &= 127;
                r.src = ((which & 1) ? p.w_mem_v : p.w_mem_k) + (size_t)(which >> 1) * 2048 * 512; r.dst = WT1 + (size_t)(11264 + which * 512) * 2048; r.K = 2048; r.N = 512; }
            const int nkt = r.K / 64; r.kt = tt % nkt; r.pt = tt / nkt; return r; };
        auto loadt = [&](const WT& r, f32x4 (&v)[4]) {
#pragma unroll
            for (int i = 0; i < 4; ++i) { const int f = tid + 512 * i, row = f >> 5, c4 = f & 31; v[i] = *(const f32x4*)(r.src + (size_t)(r.kt * 64 + row) * r.N + r.pt * 128 + c4 * 4); } };
        f32x4 cur[4], nxt[4], nx2[4];
        const int t0 = t_begin + start;
        if (t0 < t_end) { const WT r0 = decode(t0); loadt(r0, cur); }
        if (t0 + stride < t_end) { const WT r1 = decode(t0 + stride); loadt(r1, nxt); }
        for (int t = t0; t < t_end; t += stride) {
            const WT r = decode(t);
            if (t + 2 * stride < t_end) { const WT rn = decode(t + 2 * stride); loadt(rn, nx2); }
            const int c0 = r.pt * 128; const int pc = r.mode == 1 ? (c0 < 2048 ? 1 : ((c0 >= 6144 && c0 < 8192) ? 2 : 0)) : 0;
#pragma unroll
            for (int i = 0; i < 4; ++i) { const int f = tid + 512 * i, row = f >> 5, c4 = f & 31;
#pragma unroll
                for (int j = 0; j < 4; ++j) { const int d = c4 * 4 + j; const int pp = pc == 1 ? 2 * (d & 63) + (d >> 6) : ((pc == 2 && d < 32) ? 2 * (d & 15) + (d >> 4) : d); tl[row * 129 + pp] = cur[i][j]; } }
            __syncthreads();
#pragma unroll
            for (int i = 0; i < 2; ++i) { const int piece = tid + 512 * i, pp = piece >> 3, kc = piece & 7; float v[8];
#pragma unroll
                for (int j = 0; j < 8; ++j) v[j] = tl[(kc * 8 + j) * 129 + pp];
                u32x4 wv = {pk_bf16(v[0], v[1]), pk_bf16(v[2], v[3]), pk_bf16(v[4], v[5]), pk_bf16(v[6], v[7])};
                *(u32x4*)(r.dst + (size_t)(r.pt * 128 + pp) * r.K + r.kt * 64 + kc * 8) = wv; }
            __syncthreads();
#pragma unroll
            for (int i = 0; i < 4; ++i) { cur[i] = nxt[i]; nxt[i] = nx2[i]; }
        }
    }
}

DI void phase0(const Params& p, LAS uchar* lds) {
    const int tid = otid(), wid = tid >> 6, lane = tid & 63, G = gridDim.x, B = blockIdx.x;
    bf16_t* WT1 = (bf16_t*)(p.ws + W_WT1);
    LAS float* tl = (LAS float*)lds;
    wconv(p, lds, 0, 2816, B, G); wconv(p, lds, 6144, 6656, B, G);
    bf16_t* A0 = (bf16_t*)(p.ws + W_A0);
    for (int row = B * 8 + wid; row < 8960; row += G * 8) {
        bf16_t* dst = A0 + (size_t)row * 2048;
        if (row >= NROW && row < MPAD) { for (int i = 0; i < 8; ++i) *(u32x2*)(dst + (i * 64 + lane) * 4) = (u32x2){0u, 0u}; continue; }
        const float* src; const float* g;
        if (row < TP) { src = p.x_prompt + (size_t)row * 2048; g = p.pre_norm; }
        else if (row < NROW) { src = p.x_sample + (size_t)(row - TP) * 2048; g = p.pre_norm; }
        else { const int q = row - MPAD; src = p.mem_prompt + (size_t)(q & 255) * 2048; g = p.mem_norm + (q >> 8) * 2048; }
        f32x4 v[8]; float ss = 0.f;
#pragma unroll
        for (int i = 0; i < 8; ++i) { v[i] = *(const f32x4*)(src + (i * 64 + lane) * 4); ss += v[i][0] * v[i][0] + v[i][1] * v[i][1] + v[i][2] * v[i][2] + v[i][3] * v[i][3]; }
        ss = wave_sum(ss); const float rs = rsqrtf(ss * (1.f / 2048.f) + 1e-6f);
#pragma unroll
        for (int i = 0; i < 8; ++i) { const f32x4 gg = *(const f32x4*)(g + (i * 64 + lane) * 4);
            *(u32x2*)(dst + (i * 64 + lane) * 4) = (u32x2){pk_bf16(v[i][0] * rs * gg[0], v[i][1] * rs * gg[1]), pk_bf16(v[i][2] * rs * gg[2], v[i][3] * rs * gg[3])}; }
    }
    float* tAc = (float*)(p.ws + W_TAC); float* tAs = (float*)(p.ws + W_TAS); float* tBc = (float*)(p.ws + W_TBC); float* tBs = (float*)(p.ws + W_TBS);
    for (int idx = B * 512 + tid; idx < MPAD * 80; idx += G * 512) {
        const int row = idx / 80, e = idx - row * 80;
        const int pos = row < TP ? row : (row < NROW ? TP + ((row - TP) & 3) : 0);
        if (e < 64) { const float inv = 1.0f / powf(10000.0f, (float)e * (1.f / 64.f)); const float ang = (float)pos * inv; tAc[row * 64 + e] = cosf(ang); tAs[row * 64 + e] = sinf(ang); }
        else { const int i = e - 64; const float inv = 1.0f / powf(500000.0f, (float)i * (1.f / 16.f)); const float ang = (float)pos * inv; tBc[row * 16 + i] = cosf(ang); tBs[row * 16 + i] = sinf(ang); }
    }
    bf16_t* WC = (bf16_t*)(p.ws + W_WC);
    for (int idx = B * 512 + tid; idx < 16 * 128 * 128; idx += G * 512) { const int s = idx & 127, t = (idx >> 7) & 127; WC[idx] = f2bf(s <= t ? p.w_spatial[idx] : 0.f); }
    float* lns = (float*)(p.ws + W_LNS);
    for (int idx = B * 512 + tid; idx < MPAD * 2; idx += G * 512) lns[idx] = 0.f;
}

DI void load_kfm(bf16x8 (&kf)[8], const bf16_t* chunk, int lane) {
#pragma unroll
    for (int ks = 0; ks < 8; ++ks) kf[ks] = *(const bf16x8*)(chunk + (size_t)(ks * 64 + lane) * 8);
}
DI void load_kf(bf16x8 (&kf)[8], const bf16_t* kp) {
#pragma unroll
    for (int ks = 0; ks < 8; ++ks) kf[ks] = *(const bf16x8*)(kp + 16 * ks);
}
DI void flash_chunk(const bf16x8 (&qf)[8], const bf16x8 (&kf)[8], int maskmode, LAS uchar* vbase, int RS, int lrow0, int lane, float& m, float& l, f32x16 (&O)[4]) {
    const int rl = lane & 31, h = lane >> 5;
    f32x16 s; for (int i = 0; i < 16; ++i) s[i] = 0.f;
#pragma unroll
    for (int ks = 0; ks < 8; ++ks) s = MFMA32(kf[ks], qf[ks], s);
    if (maskmode != 0) {
        const int mlo = maskmode == 2 ? 0 : -64, mhi = maskmode == 1 ? 0 : 64;
#pragma unroll
        for (int i = 0; i < 16; ++i) { const int dd = rl - crow(i, h); s[i] = ((dd >= mlo) & (dd <= mhi)) ? s[i] : -1e30f; }
    }
    float mx = s[0];
#pragma unroll
    for (int i = 1; i < 16; ++i) mx = fmaxf(mx, s[i]);
    mx = fmaxf(mx, __shfl_xor(mx, 32));
    const float mn = fmaxf(m, mx), alpha = __builtin_amdgcn_exp2f((m - mn) * 1.4426950408889634f), nm = -mn * 1.4426950408889634f; m = mn;
    float ls = 0.f;
#pragma unroll
    for (int i = 0; i < 16; ++i) { s[i] = __builtin_amdgcn_exp2f(fmaf(s[i], 1.4426950408889634f, nm)); ls += s[i]; }
    l = l * alpha + ls;
#pragma unroll
    for (int dt = 0; dt < 4; ++dt) O[dt] *= alpha;
    const bf16x8 pf0 = pack8(s[0], s[1], s[2], s[3], s[4], s[5], s[6], s[7]), pf1 = pack8(s[8], s[9], s[10], s[11], s[12], s[13], s[14], s[15]);
#pragma unroll
    for (int dt = 0; dt < 4; ++dt) {
        const bf16x8 v0 = tr_frag(vbase, RS, lrow0 + 4 * h, lrow0 + 8 + 4 * h, 32 * dt, lane);
        O[dt] = MFMA32(v0, pf0, O[dt]);
        const bf16x8 v1 = tr_frag(vbase, RS, lrow0 + 16 + 4 * h, lrow0 + 24 + 4 * h, 32 * dt, lane);
        O[dt] = MFMA32(v1, pf1, O[dt]);
    }
}

DI void dil_tile(const Params& p, int item, LAS uchar* lds) {
    const int tid = otid(), w = tid >> 6, lane = tid & 63, rl = lane & 31, h = lane >> 5;
    const bf16_t* P0 = (const bf16_t*)(p.ws + W_P0);
    const int branch = item >> 8, rem = item & 255, hd = rem & 7, tb = rem >> 3;
    const int r = branch == 0 ? 1 : (branch == 1 ? 4 : 16), ppr = 32 / r, res = tb / ppr, n0 = 2 * (tb % ppr);
    const int RS = 320;
#pragma unroll
    for (int i = 0; i < 12; ++i) { const int piece = tid + 512 * i, row = piece >> 4, c16 = piece & 15; const int Lk = (n0 - 1) * 128 + row;
        if (Lk >= 0) { const size_t pos = (size_t)Lk * r + res; *(LAS u32x4*)(lds + row * RS + c16 * 16) = *(const u32x4*)(P0 + pos * LD0 + 8192 + hd * 128 + c16 * 8); } }
    const int Lq = n0 * 128 + 32 * w + rl; const size_t posq = (size_t)Lq * r + res;
    bf16x8 qf[8];
#pragma unroll
    for (int ks = 0; ks < 8; ++ks) qf[ks] = *(const bf16x8*)(P0 + posq * LD0 + 6144 + hd * 128 + 16 * ks + 8 * h);
    const int c0 = n0 > 0 ? 0 : (4 - w > 0 ? 4 - w : 0);
    const bf16_t* KFD = (const bf16_t*)(p.ws + W_KFD) + (size_t)branch * 8192 * 1024 + ((size_t)(hd * r + res) * (256 / r)) * 4096;
    auto kptr = [&](int c) { const int Lk0 = n0 * 128 + 32 * w - 128 + 32 * c; return KFD + (size_t)(Lk0 >> 5) * 4096; };
    bf16x8 kfA[8], kfB[8];
    load_kfm(kfA, kptr(c0), lane);
    __syncthreads();
    f32x16 O[4]; for (int dt = 0; dt < 4; ++dt) for (int i = 0; i < 16; ++i) O[dt][i] = 0.f;
    float m = -1e30f, l = 0.f;
    for (int c = c0;;) {
        load_kfm(kfB, kptr(c < 4 ? c + 1 : 4), lane); __builtin_amdgcn_sched_barrier(0);
        flash_chunk(qf, kfA, c == 0 ? 1 : (c == 4 ? 2 : 0), lds, RS, 32 * w + 32 * c, lane, m, l, O);
        if (++c >= 5) break;
        load_kfm(kfA, kptr(c < 4 ? c + 1 : 4), lane); __builtin_amdgcn_sched_barrier(0);
        flash_chunk(qf, kfB, c == 0 ? 1 : (c == 4 ? 2 : 0), lds, RS, 32 * w + 32 * c, lane, m, l, O);
        if (++c >= 5) break;
    }
    l += __shfl_xor(l, 32);
    const float inv = 1.f / l;
    bf16_t* DO = (bf16_t*)(p.ws + W_DILO) + ((size_t)branch * 8192 + posq) * 1024 + hd * 128;
#pragma unroll
    for (int dt = 0; dt < 4; ++dt)
#pragma unroll
        for (int g4 = 0; g4 < 4; ++g4) { const int d0 = 32 * dt + 8 * g4 + 4 * h;
            *(u32x2*)(DO + d0) = (u32x2){pk_bf16(O[dt][4 * g4] * inv, O[dt][4 * g4 + 1] * inv), pk_bf16(O[dt][4 * g4 + 2] * inv, O[dt][4 * g4 + 3] * inv)}; }
    if (h == 0) { ((float*)(p.ws + W_DILM))[((size_t)branch * 8192 + posq) * 8 + hd] = m; ((float*)(p.ws + W_DILL))[((size_t)branch * 8192 + posq) * 8 + hd] = l; }
    __syncthreads();
}

DI void memp_tile(const Params& p, int item, int layer, LAS uchar* lds) {
    const int tid = otid(), w = tid >> 6, lane = tid & 63, rl = lane & 31, h = lane >> 5;
    const bf16_t* PX = (const bf16_t*)(p.ws + (layer ? W_P1 : W_P0)); const int ld = layer ? LD1 : LD0, qcol = layer ? 6144 : 10240, gcol = layer ? 6656 : 10752;
    bf16_t* CAT = (bf16_t*)(p.ws + (layer ? W_CAT1 : W_CAT0)); const int ldc = layer ? LDC1 : LDC0, ccol = layer ? 2048 : 3072;
    const bf16_t* MKV = (const bf16_t*)(p.ws + W_MEMKV) + (size_t)layer * 256 * 1024;
    const int qt = item >> 2, hd = item & 3; const int RS = 320;
#pragma unroll
    for (int i = 0; i < 8; ++i) { const int piece = tid + 512 * i, row = piece >> 4, c16 = piece & 15;
        *(LAS u32x4*)(lds + row * RS + c16 * 16) = *(const u32x4*)(MKV + (size_t)row * 1024 + 512 + hd * 128 + c16 * 8); }
    const size_t posq = (size_t)qt * 256 + 32 * w + rl;
    bf16x8 qf[8];
#pragma unroll
    for (int ks = 0; ks < 8; ++ks) qf[ks] = *(const bf16x8*)(PX + posq * ld + qcol + hd * 128 + 16 * ks + 8 * h);
    bf16x8 kfA[8], kfB[8];
    const bf16_t* KFM = (const bf16_t*)(p.ws + W_KFM) + (size_t)(layer * 4 + hd) * 8 * 4096;
    load_kfm(kfA, KFM, lane);
    __syncthreads();
    f32x16 O[4]; for (int dt = 0; dt < 4; ++dt) for (int i = 0; i < 16; ++i) O[dt][i] = 0.f;
    float m = -1e30f, l = 0.f;
    for (int c = 0; c < 8; c += 2) {
        load_kfm(kfB, KFM + (size_t)(c + 1) * 4096, lane); __builtin_amdgcn_sched_barrier(0);
        flash_chunk(qf, kfA, 0, lds, RS, 32 * c, lane, m, l, O);
        load_kfm(kfA, KFM + (size_t)(c < 6 ? c + 2 : 7) * 4096, lane); __builtin_amdgcn_sched_barrier(0);
        flash_chunk(qf, kfB, 0, lds, RS, 32 * (c + 1), lane, m, l, O);
    }
    l += __shfl_xor(l, 32);
    const float inv = 1.f / l;
#pragma unroll
    for (int dt = 0; dt < 4; ++dt)
#pragma unroll
        for (int g4 = 0; g4 < 4; ++g4) { const int d0 = 32 * dt + 8 * g4 + 4 * h;
            const u32x2 gt = *(const u32x2*)(PX + posq * ld + gcol + hd * 128 + d0);
            *(u32x2*)(CAT + posq * ldc + ccol + hd * 128 + d0) = (u32x2){pk_bf16(O[dt][4 * g4] * inv * bf_lo(gt[0]), O[dt][4 * g4 + 1] * inv * bf_hi(gt[0])),
                                                                       pk_bf16(O[dt][4 * g4 + 2] * inv * bf_lo(gt[1]), O[dt][4 * g4 + 3] * inv * bf_hi(gt[1]))}; }
    __syncthreads();
}

DI void reta_tile(const Params& p, int item, LAS uchar* lds) {
    const int tid = otid(), w = tid >> 6, lane = tid & 63, rl = lane & 31, h = lane >> 5;
    const bf16_t* P0 = (const bf16_t*)(p.ws + W_P0);
    const int c = item >> 3, hd = item & 7; const float lg = log1pf(-exp2f(-5.f - (float)hd));
    LAS uchar* Kl = lds; LAS uchar* Vl = lds + 40960;
#pragma unroll
    for (int i = 0; i < 4; ++i) { const int piece = tid + 512 * i, j = piece >> 4, c16 = piece & 15;
        const u32x4 raw = *(const u32x4*)(P0 + (size_t)(c * 128 + j) * LD0 + 1024 + hd * 128 + c16 * 8); const float dec = __expf(lg * (float)(127 - j));
        u32x4 o; for (int q = 0; q < 4; ++q) o[q] = pk_bf16(bf_lo(raw[q]) * dec, bf_hi(raw[q]) * dec);
        *(LAS u32x4*)(Kl + j * 320 + c16 * 16) = o; }
#pragma unroll
    for (int i = 0; i < 8; ++i) { const int piece = tid + 512 * i, j = piece >> 5, c16 = piece & 31;
        *(LAS u32x4*)(Vl + j * 576 + c16 * 16) = *(const u32x4*)(P0 + (size_t)(c * 128 + j) * LD0 + 2048 + hd * 256 + c16 * 8); }
    __syncthreads();
    f32x16 acc[4]; for (int dt = 0; dt < 4; ++dt) for (int i = 0; i < 16; ++i) acc[dt][i] = 0.f;
#pragma unroll
    for (int ks = 0; ks < 8; ++ks) { const bf16x8 a = tr_frag(Vl, 576, 16 * ks + 8 * h, 16 * ks + 8 * h + 4, 32 * w, lane);
#pragma unroll
        for (int dt = 0; dt < 4; ++dt) { const bf16x8 b = tr_frag(Kl, 320, 16 * ks + 8 * h, 16 * ks + 8 * h + 4, 32 * dt, lane); acc[dt] = MFMA32(a, b, acc[dt]); } }
    bf16_t* KVT = (bf16_t*)(p.ws + W_KVT) + (size_t)(c * 8 + hd) * 256 * 128;
#pragma unroll
    for (int dt = 0; dt < 4; ++dt)
#pragma unroll
        for (int i = 0; i < 16; ++i) KVT[(size_t)(32 * w + crow(i, h)) * 128 + 32 * dt + rl] = f2bf(acc[dt][i]);
    __syncthreads();
}

DI void retc_tile(const Params& p, int item, LAS uchar* lds) {
    const int tid = otid(), w = tid >> 6, lane = tid & 63, rl = lane & 31, h = lane >> 5;
    const bf16_t* P0 = (const bf16_t*)(p.ws + W_P0);
    const int c = item >> 3, hd = item & 7; const float lg = log1pf(-exp2f(-5.f - (float)hd));
    LAS uchar* Vl = lds; LAS float* red = (LAS float*)(lds + 73728);
#pragma unroll
    for (int i = 0; i < 8; ++i) { const int piece = tid + 512 * i, j = piece >> 5, c16 = piece & 31;
        *(LAS u32x4*)(Vl + j * 576 + c16 * 16) = *(const u32x4*)(P0 + (size_t)(c * 128 + j) * LD0 + 2048 + hd * 256 + c16 * 8); }
    __syncthreads();
    const int qg = w & 3, eh = w >> 2, qi = 32 * qg + rl; const size_t posq = (size_t)c * 128 + qi;
    bf16x8 qf[8];
#pragma unroll
    for (int ks = 0; ks < 8; ++ks) qf[ks] = *(const bf16x8*)(P0 + posq * LD0 + hd * 128 + 16 * ks + 8 * h);
    f32x16 acc[4]; for (int et = 0; et < 4; ++et) for (int i = 0; i < 16; ++i) acc[et][i] = 0.f;
    if (c > 0) {
        const bf16_t* ST = (const bf16_t*)(p.ws + W_STB) + (size_t)(c * 8 + hd) * 256 * 128;
#pragma unroll
        for (int ks = 0; ks < 8; ++ks)
#pragma unroll
            for (int et = 0; et < 4; ++et) { const bf16x8 a = *(const bf16x8*)(ST + (size_t)(128 * eh + 32 * et + rl) * 128 + 16 * ks + 8 * h); acc[et] = MFMA32(a, qf[ks], acc[et]); }
        const float qd = __expf(lg * (float)(qi + 1));
#pragma unroll
        for (int et = 0; et < 4; ++et) acc[et] *= qd;
    }
    bf16x8 kf[8], kfn[8];
    const bf16_t* KFR = (const bf16_t*)(p.ws + W_KFR) + ((size_t)hd * 256 + c * 4) * 4096;
    auto kptr = [&](int jc) { return KFR + (size_t)(jc < qg ? jc : qg) * 4096; };
    auto chunk = [&](const bf16x8 (&kk)[8], int jc) {
        f32x16 s; for (int i = 0; i < 16; ++i) s[i] = 0.f;
#pragma unroll
        for (int ks = 0; ks < 8; ++ks) s = MFMA32(kk[ks], qf[ks], s);
#pragma unroll
        for (int i = 0; i < 16; ++i) { const int diff = qi - (32 * jc + crow(i, h)); s[i] = diff >= 0 ? s[i] * __expf(lg * (float)diff) : 0.f; }
        const bf16x8 pf0 = pack8(s[0], s[1], s[2], s[3], s[4], s[5], s[6], s[7]), pf1 = pack8(s[8], s[9], s[10], s[11], s[12], s[13], s[14], s[15]);
#pragma unroll
        for (int et = 0; et < 4; ++et) {
            const bf16x8 a0 = tr_frag(Vl, 576, 32 * jc + 4 * h, 32 * jc + 8 + 4 * h, 128 * eh + 32 * et, lane); acc[et] = MFMA32(a0, pf0, acc[et]);
            const bf16x8 a1 = tr_frag(Vl, 576, 32 * jc + 16 + 4 * h, 32 * jc + 24 + 4 * h, 128 * eh + 32 * et, lane); acc[et] = MFMA32(a1, pf1, acc[et]);
        }
    };
    load_kfm(kf, kptr(0), lane);
    for (int jc = 0;;) {
        load_kfm(kfn, kptr(jc + 1), lane); __builtin_amdgcn_sched_barrier(0);
        chunk(kf, jc);
        if (++jc > qg) break;
        load_kfm(kf, kptr(jc + 1), lane); __builtin_amdgcn_sched_barrier(0);
        chunk(kfn, jc);
        if (++jc > qg) break;
    }
    float s1 = 0.f, s2 = 0.f;
#pragma unroll
    for (int et = 0; et < 4; ++et)
#pragma unroll
        for (int i = 0; i < 16; ++i) { const float v = acc[et][i]; s1 += v; s2 += v * v; }
    s1 += __shfl_xor(s1, 32); s2 += __shfl_xor(s2, 32);
    if (h == 0) { red[(w * 32 + rl) * 2] = s1; red[(w * 32 + rl) * 2 + 1] = s2; }
    __syncthreads();
    const float t1 = s1 + red[((w ^ 4) * 32 + rl) * 2], t2 = s2 + red[((w ^ 4) * 32 + rl) * 2 + 1];
    const float mu = t1 * (1.f / 256.f), var = t2 * (1.f / 256.f) - mu * mu, rstd = rsqrtf(fmaxf(var, 0.f) + 1e-6f);
    bf16_t* CAT0 = (bf16_t*)(p.ws + W_CAT0);
#pragma unroll
    for (int et = 0; et < 4; ++et)
#pragma unroll
        for (int g4 = 0; g4 < 4; ++g4) { const int e0 = 128 * eh + 32 * et + 8 * g4 + 4 * h;
            const f32x4 gn = *(const f32x4*)(p.ret_gn + hd * 256 + e0); const u32x2 gt = *(const u32x2*)(P0 + posq * LD0 + 4096 + hd * 256 + e0);
            const float y0 = (acc[et][4 * g4] - mu) * rstd * gn[0] * bf_lo(gt[0]), y1 = (acc[et][4 * g4 + 1] - mu) * rstd * gn[1] * bf_hi(gt[0]);
            const float y2 = (acc[et][4 * g4 + 2] - mu) * rstd * gn[2] * bf_lo(gt[1]), y3 = (acc[et][4 * g4 + 3] - mu) * rstd * gn[3] * bf_hi(gt[1]);
            *(u32x2*)(CAT0 + posq * LDC0 + hd * 256 + e0) = (u32x2){pk_bf16(y0, y1), pk_bf16(y2, y3)}; }
    __syncthreads();
}

DI void gate_tile(const Params& p, int item, LAS uchar* lds) {
    const int tid = otid(), w = tid >> 6, lane = tid & 63, rl = lane & 31, h = lane >> 5;
    const bf16_t* P1 = (const bf16_t*)(p.ws + W_P1); const float* lns = (const float*)(p.ws + W_LNS);
    const int c = item >> 3, gp = item & 7, ch0 = gp * 256;
    LAS uchar* Vl = lds;
#pragma unroll
    for (int i = 0; i < 8; ++i) { const int piece = tid + 512 * i, s = piece >> 5, c16 = piece & 31; const int pos = c * 128 + s;
        const u32x4 raw = *(const u32x4*)(P1 + (size_t)pos * LD1 + 2048 + ch0 + c16 * 8);
        const float mu = lns[2 * pos] * (1.f / 2048.f), var = lns[2 * pos + 1] * (1.f / 2048.f) - mu * mu, rstd = rsqrtf(fmaxf(var, 0.f) + 1e-6f);
        const f32x4 g0 = *(const f32x4*)(p.gmlp_ln + ch0 + c16 * 8), g1 = *(const f32x4*)(p.gmlp_ln + ch0 + c16 * 8 + 4);
        f32x4 a = {(bf_lo(raw[0]) - mu) * rstd * g0[0], (bf_hi(raw[0]) - mu) * rstd * g0[1], (bf_lo(raw[1]) - mu) * rstd * g0[2], (bf_hi(raw[1]) - mu) * rstd * g0[3]};
        f32x4 b = {(bf_lo(raw[2]) - mu) * rstd * g1[0], (bf_hi(raw[2]) - mu) * rstd * g1[1], (bf_lo(raw[3]) - mu) * rstd * g1[2], (bf_hi(raw[3]) - mu) * rstd * g1[3]};
        *(LAS u32x4*)(Vl + s * 576 + c16 * 16) = (u32x4){pk_bf16(a[0], a[1]), pk_bf16(a[2], a[3]), pk_bf16(b[0], b[1]), pk_bf16(b[2], b[3])};
        if (c == 63) { float* d = p.out + O_PGV + (size_t)s * 2048 + ch0 + c16 * 8; *(f32x4*)d = a; *(f32x4*)(d + 4) = b; } }
    __syncthreads();
    const int g = 2 * gp + (w >> 2), tq = w & 3;
    const bf16_t* WC = (const bf16_t*)(p.ws + W_WC) + (size_t)g * 128 * 128;
    f32x16 acc[4]; for (int n = 0; n < 4; ++n) for (int i = 0; i < 16; ++i) acc[n][i] = 0.f;
    for (int ks = 0; ks < 2 * tq + 2; ++ks) {
        const bf16x8 a = *(const bf16x8*)(WC + (size_t)(32 * tq + rl) * 128 + 16 * ks + 8 * h);
#pragma unroll
        for (int n = 0; n < 4; ++n) { const bf16x8 b = tr_frag(Vl, 576, 16 * ks + 8 * h, 16 * ks + 8 * h + 4, 128 * (w >> 2) + 32 * n, lane); acc[n] = MFMA32(a, b, acc[n]); }
    }
    bf16_t* CAT1 = (bf16_t*)(p.ws + W_CAT1);
    __syncthreads();
#pragma unroll
    for (int n = 0; n < 4; ++n)
#pragma unroll
        for (int i = 0; i < 16; ++i) { const int t = 32 * tq + crow(i, h);
            *(LAS bf16_t*)(Vl + t * 528 + (128 * (w >> 2) + 32 * n + rl) * 2) = f2bf(acc[n][i] + p.b_spatial[g * 128 + t]); }
    __syncthreads();
#pragma unroll
    for (int i = 0; i < 8; ++i) { const int piece = tid + 512 * i, t = piece >> 5, c16 = piece & 31; const size_t pos = (size_t)c * 128 + t;
        const u32x4 mx = *(LAS const u32x4*)(Vl + t * 528 + c16 * 16);
        const u32x4 uu = *(const u32x4*)(P1 + pos * LD1 + ch0 + c16 * 8), zz = *(const u32x4*)(P1 + pos * LD1 + 4096 + ch0 + c16 * 8); u32x4 r;
#pragma unroll
        for (int q = 0; q < 4; ++q) r[q] = pk_bf16(bf_lo(uu[q]) * bf_lo(mx[q]) * bf_lo(zz[q]), bf_hi(uu[q]) * bf_hi(mx[q]) * bf_hi(zz[q]));
        *(u32x4*)(CAT1 + pos * LDC1 + ch0 + c16 * 8) = r; }
    __syncthreads();
}

template <int HS>
DI void mini_gemm(const bf16_t* A, const bf16_t* Wt, float*  , bf16_t* O, LAS uchar* lds) {
    const int tid = otid(), w = tid >> 6, lane = tid & 63, rl = lane & 31, h = lane >> 5;
    constexpr int K = HS * 2 * 16 * 8;
    LAS float* red = (LAS float*)lds;
    for (int tile = blockIdx.x; tile < 256; tile += gridDim.x) {
        const int mt = tile & 3, nt = tile >> 2, k0 = w * (K >> 3);
        f32x16 acc; for (int i = 0; i < 16; ++i) acc[i] = 0.f;
        const bf16_t* ap = A + (size_t)(32 * mt + rl) * K + k0 + 8 * h; const bf16_t* bp = Wt + (size_t)(32 * nt + rl) * K + k0 + 8 * h;
#pragma unroll
        for (int half = 0; half < 2; ++half) {
            bf16x8 a[HS], b[HS];
#pragma unroll
            for (int q = 0; q < HS; ++q) { a[q] = *(const bf16x8*)(ap + 16 * (half * HS + q)); b[q] = *(const bf16x8*)(bp + 16 * (half * HS + q)); }
#pragma unroll
            for (int q = 0; q < HS; ++q) acc = MFMA32(a[q], b[q], acc);
        }
#pragma unroll
        for (int i = 0; i < 16; ++i) red[w * 1024 + i * 64 + lane] = acc[i];
        __syncthreads();
#pragma unroll
        for (int q = 0; q < 2; ++q) { const int idx = tid + 512 * q, i = idx >> 6, ln = idx & 63; float sum = 0.f;
#pragma unroll
            for (int ww = 0; ww < 8; ++ww) sum += red[ww * 1024 + idx];
            O[(size_t)(32 * mt + crow(i, ln >> 5)) * 2048 + 32 * nt + (ln & 31)] = f2bf(sum); }
        __syncthreads();
    }
}

template <class KF, class VF>
DI void wave_attn(LAS const float* q, int j0, int j1, KF krow, VF vrow, int lane, float& m, float& l, float (&a)[8]) {
    const int kg = lane >> 4, ds = lane & 15;
    const f32x4 q0 = *(LAS const f32x4*)(q + ds * 8), q1 = *(LAS const f32x4*)(q + ds * 8 + 4);
    for (int jb = j0; jb < j1; jb += 64) {
        float part[16];
#pragma unroll
        for (int i = 0; i < 16; ++i) { int j = jb + kg * 16 + i; j = j < j1 ? j : j1 - 1; const float* kp = krow(j) + ds * 8;
            const f32x4 k0 = *(const f32x4*)kp, k1 = *(const f32x4*)(kp + 4);
            part[i] = k0[0] * q0[0] + k0[1] * q0[1] + k0[2] * q0[2] + k0[3] * q0[3] + k1[0] * q1[0] + k1[1] * q1[1] + k1[2] * q1[2] + k1[3] * q1[3]; }
        float v8[8], v4[4], v2[2], s;
        { const bool hi = (ds & 8) != 0;
#pragma unroll
            for (int t = 0; t < 8; ++t) { const float send = hi ? part[t] : part[t + 8], keep = hi ? part[t + 8] : part[t]; v8[t] = keep + __shfl_xor(send, 8); } }
        { const bool hi = (ds & 4) != 0;
#pragma unroll
            for (int t = 0; t < 4; ++t) { const float send = hi ? v8[t] : v8[t + 4], keep = hi ? v8[t + 4] : v8[t]; v4[t] = keep + __shfl_xor(send, 4); } }
        { const bool hi = (ds & 2) != 0;
#pragma unroll
            for (int t = 0; t < 2; ++t) { const float send = hi ? v4[t] : v4[t + 2], keep = hi ? v4[t + 2] : v4[t]; v2[t] = keep + __shfl_xor(send, 2); } }
        { const bool hi = (ds & 1) != 0; const float send = hi ? v2[0] : v2[1], keep = hi ? v2[1] : v2[0]; s = keep + __shfl_xor(send, 1); }
        const bool valid = (jb + lane) < j1; s = valid ? s : -1e30f;
        const float mx = wave_max(s), mn = fmaxf(m, mx), alpha = __expf(m - mn); m = mn;
        const float pv = valid ? __expf(s - mn) : 0.f; l = l * alpha + wave_sum(pv);
#pragma unroll
        for (int t = 0; t < 8; ++t) a[t] *= alpha;
#pragma unroll
        for (int i = 0; i < 16; ++i) { int j = jb + kg * 16 + i; j = j < j1 ? j : j1 - 1; const float pj = __shfl(pv, kg * 16 + i); const float* vp = vrow(j) + ds * 8;
            const f32x4 x0 = *(const f32x4*)vp, x1 = *(const f32x4*)(vp + 4);
            a[0] += pj * x0[0]; a[1] += pj * x0[1]; a[2] += pj * x0[2]; a[3] += pj * x0[3]; a[4] += pj * x1[0]; a[5] += pj * x1[1]; a[6] += pj * x1[2]; a[7] += pj * x1[3]; }
    }
#pragma unroll
    for (int t = 0; t < 8; ++t) { a[t] += __shfl_xor(a[t], 16); a[t] += __shfl_xor(a[t], 32); }
}

DI void attn_merge_store(LAS float* mg, int t, int part, int lane, float m, float l, const float (&a)[8], const bf16_t* gate, bf16_t* dst) {
    if (part == 1 && lane < 16) { LAS float* o = mg + (t * 16 + lane) * 12; o[0] = m; o[1] = l;
#pragma unroll
        for (int q = 0; q < 8; ++q) o[2 + q] = a[q]; }
    __syncthreads();
    if (part == 0 && lane < 16) { LAS const float* o = mg + (t * 16 + lane) * 12; const float M = fmaxf(m, o[0]), w1 = __expf(m - M), w2 = __expf(o[0] - M);
        const float den = 1.f / (w1 * l + w2 * o[1]); const u32x4 gt = *(const u32x4*)(gate + 8 * lane); u32x4 r;
#pragma unroll
        for (int q = 0; q < 4; ++q) r[q] = pk_bf16((w1 * a[2 * q] + w2 * o[2 + 2 * q]) * den * bf_lo(gt[q]), (w1 * a[2 * q + 1] + w2 * o[3 + 2 * q]) * den * bf_hi(gt[q]));
        *(u32x4*)(dst + 8 * lane) = r; }
    __syncthreads();
}

DI void sdil_item(const Params& p, int item, LAS uchar* lds) {
    const int tid = otid(), w = tid >> 6, lane = tid & 63;
    const bf16_t* P0 = (const bf16_t*)(p.ws + W_P0);
    const int b = item >> 3, hd = item & 7, t = w & 3, part = w >> 2; const size_t R = TP + b * 4 + t;
    LAS float* q = (LAS float*)(lds + w * 512); LAS float* mg = (LAS float*)(lds + 4096);
    for (int dd = lane; dd < 128; dd += 64) { const int pp = dd < 32 ? 2 * (dd & 15) + (dd >> 4) : dd; q[dd] = bf2f(P0[R * LD0 + 6144 + hd * 128 + pp]); }
    __syncthreads();
    const float* newk = p.out + O_SSWAK; const float* newv = p.out + O_SSWAV;
    auto idxf = [&](int jm) { const int br = jm >> 7, j = (jm & 127) + 1; return 2048 + t - (j << (2 * br)); };
    auto krow = [&](int jm) { const int idx = idxf(jm); return idx >= 2048 ? newk + ((size_t)(b * 4 + idx - 2048) * 8 + hd) * 128 : p.cache_k + ((size_t)(b * 2048 + idx) * 8 + hd) * 128; };
    auto vrow = [&](int jm) { const int idx = idxf(jm); return idx >= 2048 ? newv + ((size_t)(b * 4 + idx - 2048) * 8 + hd) * 128 : p.cache_v + ((size_t)(b * 2048 + idx) * 8 + hd) * 128; };
    float m = -1e30f, l = 0.f, a[8] = {0.f, 0.f, 0.f, 0.f, 0.f, 0.f, 0.f, 0.f};
    const int ds = lane & 15;
    const float* ks = newk + ((size_t)(b * 4 + t) * 8 + hd) * 128 + ds * 8; const float* vs = newv + ((size_t)(b * 4 + t) * 8 + hd) * 128 + ds * 8;
    wave_attn(q, part * 192, part * 192 + 192, krow, vrow, lane, m, l, a);
    if (part == 0) {
        const f32x4 ks0 = *(const f32x4*)ks, ks1 = *(const f32x4*)(ks + 4), vs0 = *(const f32x4*)vs, vs1 = *(const f32x4*)(vs + 4);
        const f32x4 q0 = *(LAS const f32x4*)(q + ds * 8), q1 = *(LAS const f32x4*)(q + ds * 8 + 4);
        float sd = ks0[0] * q0[0] + ks0[1] * q0[1] + ks0[2] * q0[2] + ks0[3] * q0[3] + ks1[0] * q1[0] + ks1[1] * q1[1] + ks1[2] * q1[2] + ks1[3] * q1[3];
        sd += __shfl_xor(sd, 1); sd += __shfl_xor(sd, 2); sd += __shfl_xor(sd, 4); sd += __shfl_xor(sd, 8);
        const float mn = fmaxf(m, sd), al = __expf(m - mn), pw = 3.f * __expf(sd - mn); m = mn; l = l * al + pw;
        a[0] = a[0] * al + pw * vs0[0]; a[1] = a[1] * al + pw * vs0[1]; a[2] = a[2] * al + pw * vs0[2]; a[3] = a[3] * al + pw * vs0[3];
        a[4] = a[4] * al + pw * vs1[0]; a[5] = a[5] * al + pw * vs1[1]; a[6] = a[6] * al + pw * vs1[2]; a[7] = a[7] * al + pw * vs1[3];
    }
    attn_merge_store(mg, t, part, lane, m, l, a, P0 + R * LD0 + 9216 + hd * 128, (bf16_t*)(p.ws + W_CAT0) + R * LDC0 + 2048 + hd * 128);
}

DI void smem_item(const Params& p, int item, int layer, LAS uchar* lds) {
    const int tid = otid(), w = tid >> 6, lane = tid & 63;
    const bf16_t* PX = (const bf16_t*)(p.ws + (layer ? W_P1 : W_P0)); const int ld = layer ? LD1 : LD0, qcol = layer ? 6144 : 10240, gcol = layer ? 6656 : 10752;
    bf16_t* CAT = (bf16_t*)(p.ws + (layer ? W_CAT1 : W_CAT0)); const int ldc = layer ? LDC1 : LDC0, ccol = layer ? 2048 : 3072;
    const int b = item >> 2, hd = item & 3, t = w & 3, part = w >> 2; const size_t R = TP + b * 4 + t;
    LAS float* q = (LAS float*)(lds + w * 512); LAS float* mg = (LAS float*)(lds + 4096);
    for (int dd = lane; dd < 128; dd += 64) q[dd] = bf2f(PX[R * ld + qcol + hd * 128 + dd]);
    __syncthreads();
    const float* kb = p.cmem_k + ((size_t)(layer * 32 + b) * 256 * 4 + hd) * 128; const float* vb = p.cmem_v + ((size_t)(layer * 32 + b) * 256 * 4 + hd) * 128;
    auto krow = [&](int j) { return kb + (size_t)j * 512; };
    auto vrow = [&](int j) { return vb + (size_t)j * 512; };
    float m = -1e30f, l = 0.f, a[8] = {0.f, 0.f, 0.f, 0.f, 0.f, 0.f, 0.f, 0.f};
    wave_attn(q, part * 128, part * 128 + 128, krow, vrow, lane, m, l, a);
    attn_merge_store(mg, t, part, lane, m, l, a, PX + R * ld + gcol + hd * 128, CAT + R * ldc + ccol + hd * 128);
}

DI void sret_item(const Params& p, int item, LAS uchar* lds) {
    const int tid = otid(), w = tid >> 6, lane = tid & 63;
    const bf16_t* P0 = (const bf16_t*)(p.ws + W_P0);
    const int b = item >> 3, hd = item & 7; const float lg = log1pf(-exp2f(-5.f - (float)hd));
    LAS float* qn = (LAS float*)lds; LAS float* kn = qn + 512; LAS float* sc = kn + 512; LAS float* gr = sc + 16; LAS float* red = gr + 48;
    const size_t R0 = TP + b * 4;
    { const int t = tid >> 7, d = tid & 127, pp = 2 * (d & 63) + (d >> 6);
        qn[t * 128 + d] = bf2f(P0[(R0 + t) * LD0 + hd * 128 + pp]); kn[t * 128 + d] = bf2f(P0[(R0 + t) * LD0 + 1024 + hd * 128 + pp]); }
    f32x4 v[4];
#pragma unroll
    for (int t = 0; t < 4; ++t) { const u32x2 r = *(const u32x2*)(P0 + (R0 + t) * LD0 + 2048 + hd * 256 + 4 * lane); v[t] = (f32x4){bf_lo(r[0]), bf_hi(r[0]), bf_lo(r[1]), bf_hi(r[1])}; }
    __syncthreads();
    if (tid < 16) { const int i = tid >> 2, j = tid & 3; float s = 0.f; for (int d = 0; d < 128; ++d) s += qn[i * 128 + d] * kn[j * 128 + d]; sc[tid] = j <= i ? s * __expf(lg * (float)(i - j)) : 0.f; }
    const float g1 = __expf(lg), g2 = g1 * g1, g3 = g2 * g1, g4 = g2 * g2;
    const float* sin_ = p.state_ret + ((size_t)(b * 8 + hd) * 128) * 256 + 4 * lane; float* sout = p.out + O_SSTATE + ((size_t)(b * 8 + hd) * 128) * 256 + 4 * lane;
    f32x4 cr[4]; for (int i = 0; i < 4; ++i) cr[i] = (f32x4){0.f, 0.f, 0.f, 0.f};
    const f32x4 kv0 = g3 * v[0], kv1 = g2 * v[1], kv2 = g1 * v[2], kv3 = v[3];
    f32x4 st[16];
#pragma unroll
    for (int dd = 0; dd < 16; ++dd) st[dd] = *(const f32x4*)(sin_ + (size_t)(16 * w + dd) * 256);
#pragma unroll
    for (int dd = 0; dd < 16; ++dd) { const int d = 16 * w + dd;
        cr[0] += qn[d] * st[dd]; cr[1] += qn[128 + d] * st[dd]; cr[2] += qn[256 + d] * st[dd]; cr[3] += qn[384 + d] * st[dd];
        *(f32x4*)(sout + (size_t)d * 256) = g4 * st[dd] + kn[d] * kv0 + kn[128 + d] * kv1 + kn[256 + d] * kv2 + kn[384 + d] * kv3; }
#pragma unroll
    for (int i = 0; i < 4; ++i) *(LAS f32x4*)(red + (w * 4 + i) * 256 + 4 * lane) = cr[i];
    __syncthreads();
    const int e = tid & 255; float o[4] = {0.f, 0.f, 0.f, 0.f};
    if (tid < 256) {
        float ve[4];
#pragma unroll
        for (int t = 0; t < 4; ++t) ve[t] = bf2f(P0[(R0 + t) * LD0 + 2048 + hd * 256 + e]);
        const float gp[4] = {g1, g2, g3, g4};
#pragma unroll
        for (int i = 0; i < 4; ++i) { float x = 0.f;
#pragma unroll
            for (int ww = 0; ww < 8; ++ww) x += red[(ww * 4 + i) * 256 + e];
            x *= gp[i];
#pragma unroll
            for (int j = 0; j < 4; ++j) if (j <= i) x += sc[i * 4 + j] * ve[j];
            o[i] = x; }
#pragma unroll
        for (int i = 0; i < 4; ++i) { const float aa = wave_sum(o[i]), bq = wave_sum(o[i] * o[i]); if (lane == 0) { gr[(w * 4 + i) * 2] = aa; gr[(w * 4 + i) * 2 + 1] = bq; } }
    }
    __syncthreads();
    if (tid < 256) {
        bf16_t* CAT0 = (bf16_t*)(p.ws + W_CAT0); const float gn = p.ret_gn[hd * 256 + e];
#pragma unroll
        for (int i = 0; i < 4; ++i) { float t1 = 0.f, t2 = 0.f; for (int ww = 0; ww < 4; ++ww) { t1 += gr[(ww * 4 + i) * 2]; t2 += gr[(ww * 4 + i) * 2 + 1]; }
            const float mu = t1 * (1.f / 256.f), var = t2 * (1.f / 256.f) - mu * mu, rstd = rsqrtf(fmaxf(var, 0.f) + 1e-6f);
            CAT0[(R0 + i) * LDC0 + hd * 256 + e] = f2bf((o[i] - mu) * rstd * gn * bf2f(P0[(R0 + i) * LD0 + 4096 + hd * 256 + e])); }
    }
    __syncthreads();
}

DI void sgate_item(const Params& p, int b) {
    const int tid = otid(); const int ch = tid * 4, g = ch >> 7;
    const bf16_t* P1 = (const bf16_t*)(p.ws + W_P1); const float* lns = (const float*)(p.ws + W_LNS); bf16_t* CAT1 = (bf16_t*)(p.ws + W_CAT1);
    const size_t R0 = TP + b * 4;
    const f32x4 gl = *(const f32x4*)(p.gmlp_ln + ch);
    f32x4 vn[4];
#pragma unroll
    for (int t = 0; t < 4; ++t) { const size_t R = R0 + t; const u32x2 raw = *(const u32x2*)(P1 + R * LD1 + 2048 + ch);
        const float mu = lns[2 * R] * (1.f / 2048.f), var = lns[2 * R + 1] * (1.f / 2048.f) - mu * mu, rstd = rsqrtf(fmaxf(var, 0.f) + 1e-6f);
        vn[t] = (f32x4){(bf_lo(raw[0]) - mu) * rstd * gl[0], (bf_hi(raw[0]) - mu) * rstd * gl[1], (bf_lo(raw[1]) - mu) * rstd * gl[2], (bf_hi(raw[1]) - mu) * rstd * gl[3]};
        *(f32x4*)(p.out + O_SGV + (size_t)(b * 4 + t) * 2048 + ch) = vn[t]; }
#pragma unroll
    for (int t = 0; t < 4; ++t) { const size_t R = R0 + t; const float bias = p.b_spatial[g * 128 + t]; f32x4 mixed = {bias, bias, bias, bias};
#pragma unroll
        for (int s = 0; s < 4; ++s) if (s <= t) mixed += p.w_spatial[(size_t)g * 16384 + t * 128 + s] * vn[s];
        const u32x2 ur = *(const u32x2*)(P1 + R * LD1 + ch), zr = *(const u32x2*)(P1 + R * LD1 + 4096 + ch);
        *(u32x2*)(CAT1 + R * LDC1 + ch) = (u32x2){pk_bf16(bf_lo(ur[0]) * mixed[0] * bf_lo(zr[0]), bf_hi(ur[0]) * mixed[1] * bf_hi(zr[0])),
                                                  pk_bf16(bf_lo(ur[1]) * mixed[2] * bf_lo(zr[1]), bf_hi(ur[1]) * mixed[3] * bf_hi(zr[1]))}; }
}

DI void phase3(const Params& p) {
    int G = gridDim.x; asm volatile("" : "+s"(G));
    const int tid = otid(), B = blockIdx.x;
    const bf16_t* KVT = (const bf16_t*)(p.ws + W_KVT); bf16_t* STB = (bf16_t*)(p.ws + W_STB);
    for (int idx = B * 512 + tid; idx < 131072; idx += G * 512) {
        const int d2 = idx & 63, e = (idx >> 6) & 255, hd = idx >> 14;
        const float gd = __expf(128.f * log1pf(-exp2f(-5.f - (float)hd)));
        const size_t off = ((size_t)hd * 256 + e) * 128 + 2 * d2;
        float s0 = 0.f, s1 = 0.f;
#pragma unroll 16
        for (int c = 0; c < 64; ++c) { const unsigned kr = *(const unsigned*)(KVT + (size_t)c * 262144 + off); const f32x2 kv = {bf_lo(kr), bf_hi(kr)};
            *(unsigned*)(STB + (size_t)c * 262144 + off) = pk_bf16(s0, s1);
            s0 = gd * s0 + kv[0]; s1 = gd * s1 + kv[1]; }
        p.out[O_PSTATE + ((size_t)hd * 128 + d2) * 256 + e] = s0; p.out[O_PSTATE + ((size_t)hd * 128 + d2 + 64) * 256 + e] = s1;
    }
    const bf16_t* DO = (const bf16_t*)(p.ws + W_DILO); const float* DM = (const float*)(p.ws + W_DILM); const float* DL = (const float*)(p.ws + W_DILL);
    const bf16_t* P0 = (const bf16_t*)(p.ws + W_P0); bf16_t* CAT0 = (bf16_t*)(p.ws + W_CAT0);
#pragma unroll 2
    for (int idx = B * 512 + tid; idx < 8192 * 8 * 16; idx += G * 512) {
        const int c16 = idx & 15, hd = (idx >> 4) & 7; const size_t pos = idx >> 7;
        float mm[3], ll[3]; for (int b = 0; b < 3; ++b) { mm[b] = DM[((size_t)b * 8192 + pos) * 8 + hd]; ll[b] = DL[((size_t)b * 8192 + pos) * 8 + hd]; }
        const float M = fmaxf(mm[0], fmaxf(mm[1], mm[2])); float wt[3], den = 0.f; for (int b = 0; b < 3; ++b) { wt[b] = __expf(mm[b] - M) * ll[b]; den += wt[b]; }
        const float inv = 1.f / den; float acc[8] = {0.f, 0.f, 0.f, 0.f, 0.f, 0.f, 0.f, 0.f};
#pragma unroll
        for (int b = 0; b < 3; ++b) { const u32x4 o = *(const u32x4*)(DO + ((size_t)b * 8192 + pos) * 1024 + hd * 128 + c16 * 8); const float ww = wt[b] * inv;
#pragma unroll
            for (int q = 0; q < 4; ++q) { acc[2 * q] += ww * bf_lo(o[q]); acc[2 * q + 1] += ww * bf_hi(o[q]); } }
        const u32x4 gt = *(const u32x4*)(P0 + pos * LD0 + 9216 + hd * 128 + c16 * 8); u32x4 r;
#pragma unroll
        for (int q = 0; q < 4; ++q) r[q] = pk_bf16(acc[2 * q] * bf_lo(gt[q]), acc[2 * q + 1] * bf_hi(gt[q]));
        *(u32x4*)(CAT0 + pos * LDC0 + 2048 + hd * 128 + c16 * 8) = r;
    }
}

DI void load_o8(const bf16_t* os, int lane, f32x4 (&v)[8]) {
#pragma unroll
    for (int i = 0; i < 4; ++i) { const u32x4 r = *(const u32x4*)(os + (i * 64 + lane) * 8);
        v[2 * i] = (f32x4){bf_lo(r[0]), bf_hi(r[0]), bf_lo(r[1]), bf_hi(r[1])}; v[2 * i + 1] = (f32x4){bf_lo(r[2]), bf_hi(r[2]), bf_lo(r[3]), bf_hi(r[3])}; }
}
DI int o8_off(int i, int lane) { return ((i >> 1) * 64 + lane) * 8 + (i & 1) * 4; }
DI void phase6(const Params& p) {
    const int tid = otid(), wid = tid >> 6, lane = tid & 63, G = gridDim.x, B = blockIdx.x;
    const bf16_t* O = (const bf16_t*)(p.ws + W_O); bf16_t* XN1 = (bf16_t*)(p.ws + W_XN1);
    for (int row = B * 8 + wid; row < MPAD; row += G * 8) {
        bf16_t* dst = XN1 + (size_t)row * 2048;
        if (row >= NROW) { for (int i = 0; i < 8; ++i) *(u32x2*)(dst + (i * 64 + lane) * 4) = (u32x2){0u, 0u}; continue; }
        const float* xs = row < TP ? p.x_prompt + (size_t)row * 2048 : p.x_sample + (size_t)(row - TP) * 2048;
        float* hd = p.out + O_Y + (size_t)row * 2048;
        f32x4 v[8], x[8]; float ss = 0.f;
        load_o8(O + (size_t)row * 2048, lane, v);
#pragma unroll
        for (int i = 0; i < 8; ++i) x[i] = *(const f32x4*)(xs + o8_off(i, lane));
#pragma unroll
        for (int i = 0; i < 8; ++i) ss += v[i][0] * v[i][0] + v[i][1] * v[i][1] + v[i][2] * v[i][2] + v[i][3] * v[i][3];
        ss = wave_sum(ss); const float rs = rsqrtf(ss * (1.f / 2048.f) + 1e-6f); float s2 = 0.f;
#pragma unroll
        for (int i = 0; i < 8; ++i) { const f32x4 g = *(const f32x4*)(p.post_norm + o8_off(i, lane));
            v[i] = x[i] + v[i] * rs * g; *(f32x4*)(hd + o8_off(i, lane)) = v[i]; s2 += v[i][0] * v[i][0] + v[i][1] * v[i][1] + v[i][2] * v[i][2] + v[i][3] * v[i][3]; }
        s2 = wave_sum(s2); const float r2 = rsqrtf(s2 * (1.f / 2048.f) + 1e-6f);
#pragma unroll
        for (int i = 0; i < 4; ++i) { const f32x4 g0 = *(const f32x4*)(p.pre_norm + 2048 + o8_off(2 * i, lane)), g1 = *(const f32x4*)(p.pre_norm + 2048 + o8_off(2 * i + 1, lane));
            const f32x4 a = v[2 * i] * r2 * g0, b = v[2 * i + 1] * r2 * g1;
            *(u32x4*)(dst + (i * 64 + lane) * 8) = (u32x4){pk_bf16(a[0], a[1]), pk_bf16(a[2], a[3]), pk_bf16(b[0], b[1]), pk_bf16(b[2], b[3])}; }
    }
}

DI void phase10(const Params& p) {
    const int tid = otid(), wid = tid >> 6, lane = tid & 63, G = gridDim.x, B = blockIdx.x;
    const bf16_t* O = (const bf16_t*)(p.ws + W_O);
    for (int row = B * 8 + wid; row < NROW; row += G * 8) {
        float* hd = p.out + O_Y + (size_t)row * 2048;
        f32x4 v[8], x[8]; float ss = 0.f;
        load_o8(O + (size_t)row * 2048, lane, v);
#pragma unroll
        for (int i = 0; i < 8; ++i) x[i] = *(const f32x4*)(hd + o8_off(i, lane));
#pragma unroll
        for (int i = 0; i < 8; ++i) ss += v[i][0] * v[i][0] + v[i][1] * v[i][1] + v[i][2] * v[i][2] + v[i][3] * v[i][3];
        ss = wave_sum(ss); const float rs = rsqrtf(ss * (1.f / 2048.f) + 1e-6f);
#pragma unroll
        for (int i = 0; i < 8; ++i) { const f32x4 g = *(const f32x4*)(p.post_norm + 2048 + o8_off(i, lane));
            *(f32x4*)(hd + o8_off(i, lane)) = x[i] + v[i] * rs * g; }
    }
}

#ifndef REP_DIL
#define REP_DIL 1
#endif
#ifndef REP_RETA
#define REP_RETA 1
#endif
#ifndef REP_MEM
#define REP_MEM 1
#endif
#ifndef REP_SRET
#define REP_SRET 1
#endif
#ifndef REP_SDIL
#define REP_SDIL 1
#endif
#ifndef REP_P3
#define REP_P3 1
#endif
#ifndef REP_P4
#define REP_P4 1
#endif
#ifndef REP_P8
#define REP_P8 1
#endif
#ifndef REP_P0
#define REP_P0 1
#endif
#ifndef REP_G1
#define REP_G1 1
#endif
#ifndef REP_P2
#define REP_P2 1
#endif
__global__ void __launch_bounds__(512) mega_fwd(Params p) {
    extern __shared__ __attribute__((aligned(16))) uchar smem[];
    LAS uchar* lds = (LAS uchar*)smem;
    cg::grid_group grid = cg::this_grid();
    const int G = gridDim.x, B = blockIdx.x;
    uchar* ws = p.ws;
    if (otid() < 4) ((LAS unsigned*)(lds + LDS_BAR_OFF))[otid()] = 0u;
    __syncthreads();
    XcdBarrier xb = xcd_barrier_post((unsigned*)(ws + W_BAR), (volatile LAS unsigned*)(lds + LDS_BAR_OFF));
    if (p.out == nullptr) grid.sync();

    for (int rep = 0; rep < REP_P0; ++rep) phase0(p, lds);
    xcd_barrier(xb);
    {
        pg8::Gemm g{(const bf16_t*)(ws + W_A0), (const bf16_t*)(ws + W_WT1), MPAD, LD0, 2048};
        pg8::StaticOrder S; S.init(MPAD, LD0, G, B, 8);
        Epi1 E{(bf16_t*)(ws + W_P0), (bf16_t*)(ws + W_MEMKV), p.out, (const float*)(ws + W_TAC), (const float*)(ws + W_TAS), (const float*)(ws + W_TBC), (const float*)(ws + W_TBS), (bf16_t*)(ws + W_KFD), (bf16_t*)(ws + W_KFR), (bf16_t*)(ws + W_KFM)};
        { const int rem = 1460 % G;
          if (rem > 0) { if (B >= rem) wconv(p, lds, 2816, 5504, B - rem, G - rem); } else wconv(p, lds, 2816, 5504, B, G); }
        for (int rep = 0; rep < REP_G1; ++rep) pg8::gemm_phase(lds, g, S, E);
    }
    xcd_barrier(xb);
    for (int rep = 0; rep < REP_P2; ++rep)
    for (int it = B; it < 2048; it += G) {
        const int item = ((B & 1) && G == 256) ? ((it + 1280) & 2047) : it;
        if (item < 768) { for (int q = 0; q < REP_DIL; ++q) dil_tile(p, item, lds); }
        else if (item < 1280) { for (int q = 0; q < REP_RETA; ++q) reta_tile(p, item - 768, lds); }
        else if (item < 1408) { for (int q = 0; q < REP_MEM; ++q) memp_tile(p, item - 1280, 0, lds); }
        else if (item < 1664) { for (int q = 0; q < REP_SRET; ++q) sret_item(p, item - 1408, lds); }
        else if (item < 1920) { for (int q = 0; q < REP_SDIL; ++q) sdil_item(p, item - 1664, lds); }
        else { for (int q = 0; q < REP_MEM; ++q) smem_item(p, item - 1920, 0, lds); }
    }
    xcd_barrier(xb);
    for (int rep = 0; rep < REP_P3; ++rep) phase3(p);
    xcd_barrier(xb);
    for (int rep = 0; rep < REP_P4; ++rep)
    for (int item = B; item < 512; item += G) retc_tile(p, item, lds);
    xcd_barrier(xb);
    {
        pg8::Gemm g{(const bf16_t*)(ws + W_CAT0), (const bf16_t*)(ws + W_WT2), TP, 2048, LDC0};
        pg8::StaticOrder S; S.init(TP, 2048, G, B, 0);
        EpiO E{(bf16_t*)(ws + W_O)};
        pg8::gemm_phase(lds, g, S, E);
        mini_gemm<14>((const bf16_t*)(ws + W_CAT0) + (size_t)TP * LDC0, (const bf16_t*)(ws + W_WT2), nullptr, (bf16_t*)(ws + W_O) + (size_t)TP * 2048, lds);
    }
    xcd_barrier(xb);
    phase6(p);
    xcd_barrier(xb);
    {
        pg8::Gemm g{(const bf16_t*)(ws + W_XN1), (const bf16_t*)(ws + W_WT3), MPAD, LD1, 2048};
        pg8::StaticOrder S; S.init(MPAD, LD1, G, B, 0);
        Epi3 E{(bf16_t*)(ws + W_P1), (float*)(ws + W_LNS)};
        { const int rem = 924 % G;
          if (rem > 0) { if (B >= rem) wconv(p, lds, 5504, 6144, B - rem, G - rem); } else wconv(p, lds, 5504, 6144, B, G); }
        pg8::gemm_phase(lds, g, S, E);
    }
    xcd_barrier(xb);
    for (int rep = 0; rep < REP_P8; ++rep)
    for (int item = B; item < 800; item += G) {
        if (item < 512) gate_tile(p, item, lds);
        else if (item < 640) memp_tile(p, item - 512, 1, lds);
        else if (item < 768) smem_item(p, item - 640, 1, lds);
        else sgate_item(p, item - 768);
    }
    xcd_barrier(xb);
    {
        pg8::Gemm g{(const bf16_t*)(ws + W_CAT1), (const bf16_t*)(ws + W_WT4), TP, 2048, LDC1};
        pg8::StaticOrder S; S.init(TP, 2048, G, B, 0);
        EpiO E{(bf16_t*)(ws + W_O)};
        pg8::gemm_phase(lds, g, S, E);
        mini_gemm<10>((const bf16_t*)(ws + W_CAT1) + (size_t)TP * LDC1, (const bf16_t*)(ws + W_WT4), nullptr, (bf16_t*)(ws + W_O) + (size_t)TP * 2048, lds);
    }
    xcd_barrier(xb);
    phase10(p);
}

extern "C" void kernel_launch(void* const* d_in, const int* in_sizes, int n_in, void* d_out, int out_size, void* d_ws, size_t ws_size, hipStream_t stream) {
    static int grid_blocks = 0;
    if (!grid_blocks) {
        int dev = 0, cus = 0, per_cu = 0;
        hipGetDevice(&dev);
        hipDeviceGetAttribute(&cus, hipDeviceAttributeMultiprocessorCount, dev);
        hipFuncSetAttribute((const void*)mega_fwd, hipFuncAttributeMaxDynamicSharedMemorySize, LDS_BYTES);
        hipOccupancyMaxActiveBlocksPerMultiprocessor(&per_cu, (const void*)mega_fwd, 512, LDS_BYTES);
        if (per_cu < 1) { fprintf(stderr, "occupancy query returned %d\n", per_cu); per_cu = 1; }
        grid_blocks = cus;
        if (ws_size < W_END) fprintf(stderr, "workspace too small: %zu < %zu\n", ws_size, (size_t)W_END);
    }
    Params p{};
    const float** pp = (const float**)&p;
    for (int i = 0; i < 21; ++i) pp[i] = (const float*)d_in[i];
    p.out = (float*)d_out; p.ws = (uchar*)d_ws;
    (void)hipMemsetAsync((uchar*)d_ws + W_BAR, 0, (size_t)XCD_BAR_WORDS_C * 4, stream);
    void* args[] = {&p};
    hipError_t e = hipLaunchCooperativeKernel((const void*)mega_fwd, dim3(grid_blocks), dim3(512), args, LDS_BYTES, stream);
    if (e != hipSuccess) fprintf(stderr, "cooperative launch failed: %s (grid %d)\n", hipGetErrorString(e), grid_blocks);
}
```

```cpp
#include <hip/hip_runtime.h>
#include <hip/hip_cooperative_groups.h>
#include <cstdio>
namespace cg = cooperative_groups;

#define DI __device__ __forceinline__
#define LAS __attribute__((address_space(3)))
typedef unsigned short bf16_t;
typedef unsigned char uchar;
typedef short bf16x8 __attribute__((ext_vector_type(8)));
typedef short s16x4 __attribute__((ext_vector_type(4)));
typedef float f32x4 __attribute__((ext_vector_type(4)));
typedef float f32x2 __attribute__((ext_vector_type(2)));
typedef float f32x16 __attribute__((ext_vector_type(16)));
typedef unsigned u32x2 __attribute__((ext_vector_type(2)));
typedef unsigned u32x4 __attribute__((ext_vector_type(4)));
typedef __bf16 bfv2 __attribute__((ext_vector_type(2)));

#define MFMA32(a, b, c) __builtin_amdgcn_mfma_f32_32x32x16_bf16((a), (b), (c), 0, 0, 0)

constexpr int TP = 8192;
constexpr int NROW = 8320;
constexpr int MPAD = 8448;
constexpr int LD0 = 11264, LD1 = 7168, LDC0 = 3584, LDC1 = 2560;
constexpr float RSQ128 = 0.08838834764831845f;
constexpr int LDS_BYTES = 139264;
constexpr int XCD_BAR_WORDS_C = 3456;
constexpr int LDS_BAR_OFF = LDS_BYTES - 16;

constexpr size_t O_Y = 0, O_PSTATE = 17039360, O_PSWAK = 17301504, O_PSWAV = 19398656, O_PMEMK = 21495808,
                 O_PMEMV = 21757952, O_PGV = 22020096, O_SSTATE = 22282240, O_SSWAK = 30670848, O_SSWAV = 30801920, O_SGV = 30932992;

constexpr size_t al256(size_t x) { return (x + 255) & ~(size_t)255; }
constexpr size_t W_A0 = 0;
constexpr size_t W_WT1 = al256(W_A0 + (size_t)8960 * 2048 * 2);
constexpr size_t W_WT2 = al256(W_WT1 + (size_t)13312 * 2048 * 2);
constexpr size_t W_WT3 = al256(W_WT2 + (size_t)2048 * 3584 * 2);
constexpr size_t W_WT4 = al256(W_WT3 + (size_t)7168 * 2048 * 2);
constexpr size_t W_P0 = al256(W_WT4 + (size_t)2048 * 2560 * 2);
constexpr size_t W_MEMKV = al256(W_P0 + (size_t)MPAD * LD0 * 2);
constexpr size_t W_KVT = al256(W_MEMKV + (size_t)2 * 256 * 1024 * 2);
constexpr size_t W_STB = al256(W_KVT + (size_t)512 * 256 * 128 * 4);
constexpr size_t W_DILO = al256(W_STB + (size_t)512 * 256 * 128 * 2);
constexpr size_t W_DILM = al256(W_DILO + (size_t)3 * 8192 * 1024 * 2);
constexpr size_t W_DILL = al256(W_DILM + (size_t)3 * 8192 * 8 * 4);
constexpr size_t W_CAT0 = al256(W_DILL + (size_t)3 * 8192 * 8 * 4);
constexpr size_t W_O = al256(W_CAT0 + (size_t)MPAD * LDC0 * 2);
constexpr size_t W_XN1 = al256(W_O + (size_t)MPAD * 2048 * 4);
constexpr size_t W_P1 = al256(W_XN1 + (size_t)MPAD * 2048 * 2);
constexpr size_t W_LNS = al256(W_P1 + (size_t)MPAD * LD1 * 2);
constexpr size_t W_CAT1 = al256(W_LNS + (size_t)MPAD * 2 * 4);
constexpr size_t W_TAC = al256(W_CAT1 + (size_t)MPAD * LDC1 * 2);
constexpr size_t W_TAS = al256(W_TAC + (size_t)MPAD * 64 * 4);
constexpr size_t W_TBC = al256(W_TAS + (size_t)MPAD * 64 * 4);
constexpr size_t W_TBS = al256(W_TBC + (size_t)MPAD * 16 * 4);
constexpr size_t W_WC = al256(W_TBS + (size_t)MPAD * 16 * 4);
constexpr size_t W_KFD = al256(W_WC + (size_t)16 * 128 * 128 * 2);
constexpr size_t W_KFR = al256(W_KFD + (size_t)3 * 8192 * 1024 * 2);
constexpr size_t W_KFM = al256(W_KFR + (size_t)8192 * 1024 * 2);
constexpr size_t W_BAR = al256(W_KFM + (size_t)2 * 256 * 512 * 2);
constexpr size_t W_END = al256(W_BAR + (size_t)XCD_BAR_WORDS_C * 4);

struct Params {
    const float *x_prompt, *x_sample, *state_ret, *cache_k, *cache_v, *cmem_k, *cmem_v, *mem_prompt, *pre_norm, *post_norm, *mem_norm,
        *w_mem_k, *w_mem_v, *w_in_even, *ret_gn, *w_out_even, *w_in_odd, *gmlp_ln, *w_spatial, *b_spatial, *w_out_odd;
    float* out;
    uchar* ws;
};

DI int otid() { int t = __builtin_amdgcn_workitem_id_x(); asm volatile("" : "+v"(t)); return t; }
DI unsigned pk_bf16(float lo, float hi) { f32x2 v = {lo, hi}; bfv2 b = __builtin_convertvector(v, bfv2); return __builtin_bit_cast(unsigned, b); }
DI bf16_t f2bf(float x) { return (bf16_t)(pk_bf16(x, 0.f) & 0xffffu); }
DI float bf_lo(unsigned u) { return __uint_as_float(u << 16); }
DI float bf_hi(unsigned u) { return __uint_as_float(u & 0xffff0000u); }
DI float bf2f(bf16_t b) { return __uint_as_float(((unsigned)b) << 16); }
DI float wave_sum(float v) { for (int o = 32; o > 0; o >>= 1) v += __shfl_xor(v, o); return v; }
DI float wave_max(float v) { for (int o = 32; o > 0; o >>= 1) v = fmaxf(v, __shfl_xor(v, o)); return v; }
DI float silu_f(float x) { return x * __builtin_amdgcn_rcpf(1.f + __expf(-x)); }
DI float gelu_f(float x) { const float u = 0.7978845608028654f * (x + 0.044715f * x * x * x); return x * __builtin_amdgcn_rcpf(1.f + __expf(-2.f * u)); }
DI int crow(int i, int h) { return (i & 3) + 8 * (i >> 2) + 4 * h; }
DI bf16x8 pack8(float a, float b, float c, float d, float e, float f, float g, float h) {
    u32x4 p = {pk_bf16(a, b), pk_bf16(c, d), pk_bf16(e, f), pk_bf16(g, h)}; return __builtin_bit_cast(bf16x8, p); }
DI s16x4 trr(LAS uchar* a) { return __builtin_amdgcn_ds_read_tr16_b64_v4i16((LAS s16x4*)a); }
DI bf16x8 tr_frag(LAS uchar* base, int RS, int krow_lo, int krow_hi, int col0, int lane) {
    const int i16 = lane & 15, q = i16 >> 2, pq = i16 & 3, blk = (lane >> 4) & 1;
    const int cb = (col0 + 16 * blk) * 2 + 8 * pq;
    s16x4 lo = trr(base + (krow_lo + q) * RS + cb);
    s16x4 hi = trr(base + (krow_hi + q) * RS + cb);
    return __builtin_shufflevector(lo, hi, 0, 1, 2, 3, 4, 5, 6, 7);
}

#define XB_TMO      128
#define XB_XCNT(j)  (256  + 64 * (j))
#define XB_XSUB(j)  (1280 + 64 * (j))
#define XB_XGEN(j)  (2304 + 64 * (j))
#define XB_TOP      3328
#define XB_TOPGEN   3392
#define XCD_BAR_WORDS 3456
#define XB_SPIN_CAP (1u << 22)
DI unsigned xb_ld(unsigned* p) { return __hip_atomic_load(p, __ATOMIC_RELAXED, __HIP_MEMORY_SCOPE_AGENT); }
DI unsigned xb_add(unsigned* p, unsigned v) { return __hip_atomic_fetch_add(p, v, __ATOMIC_RELAXED, __HIP_MEMORY_SCOPE_AGENT); }
DI unsigned xb_xcc_id() { return (unsigned)__builtin_amdgcn_s_getreg((3 << 11) | 20) & 0xFu; }
#define XB_SPIN(cond, bar) do { unsigned _sp = 0; while (cond) { __builtin_amdgcn_s_sleep(1); \
    if ((++_sp & 255u) == 0u) { if (xb_ld(&(bar)[XB_TMO])) break; if (_sp > XB_SPIN_CAP) { atomicAdd(&(bar)[XB_TMO], 1u); break; } } } } while (0)
struct XcdBarrier { unsigned* bar; unsigned x; volatile LAS unsigned* st; };
DI XcdBarrier xcd_barrier_post(unsigned* bar, volatile LAS unsigned* st) {
    XcdBarrier b; b.bar = bar; b.x = xb_xcc_id(); b.st = st;
    if (otid() == 0) (void)xb_add(&bar[XB_XCNT(b.x)], 1u);
    return b;
}
DI void xcd_barrier_complete(unsigned* bar, unsigned x, unsigned& nloc, unsigned& nx) {
    const unsigned G = gridDim.x;
    unsigned sum, cnt, mine, sp = 0u;
    for (;;) {
        sum = 0u; cnt = 0u; mine = 0u;
#pragma unroll
        for (unsigned j = 0; j < 16; ++j) { const unsigned c = xb_ld(&bar[XB_XCNT(j)]); sum += c; cnt += (c > 0u) ? 1u : 0u; mine = (j == x) ? c : mine; }
        if (sum == G) break;
        __builtin_amdgcn_s_sleep(1);
        if ((++sp & 255u) == 0u) { if (xb_ld(&bar[XB_TMO])) break; if (sp > XB_SPIN_CAP) { atomicAdd(&bar[XB_TMO], 1u); break; } }
    }
    nloc = mine > 0u ? mine : 1u; nx = cnt > 0u ? cnt : 1u;
}
DI void xcd_barrier(const XcdBarrier& b) {
    asm volatile("s_waitcnt vmcnt(0)" ::: "memory");
    __syncthreads();
    if (otid() == 0) {
        unsigned* bar = b.bar;
        const unsigned bx = xb_xcc_id();
        __builtin_amdgcn_s_waitcnt(0);
        unsigned nloc = b.st[0], nx = b.st[1];
        if (nloc == 0u) { xcd_barrier_complete(bar, bx, nloc, nx); b.st[0] = nloc; b.st[1] = nx; }
        const unsigned old = xb_add(&bar[XB_XSUB(bx)], 1u);
        const unsigned gen = old / nloc;
        if (old + 1u == (gen + 1u) * nloc) {
            __builtin_amdgcn_fence(__ATOMIC_RELEASE, "agent");
            asm volatile("s_waitcnt vmcnt(0)" ::: "memory");
            const unsigned og = xb_add(&bar[XB_TOP], 1u);
            const unsigned tg = og / nx;
            if (og + 1u == (tg + 1u) * nx) xb_add(&bar[XB_TOPGEN], 1u);
            else XB_SPIN(xb_ld(&bar[XB_TOPGEN]) == tg, bar);
            __builtin_amdgcn_fence(__ATOMIC_ACQUIRE, "agent");
            xb_add(&bar[XB_XGEN(bx)], 1u);
            asm volatile("s_waitcnt vmcnt(0)" ::: "memory");
        } else {
            XB_SPIN(xb_ld(&bar[XB_XGEN(bx)]) == gen, bar);
            __builtin_amdgcn_fence(__ATOMIC_ACQUIRE, "agent");
            asm volatile("s_waitcnt vmcnt(0)" ::: "memory");
        }
    }
    __syncthreads();
}

namespace pg8 {
constexpr int BM = 256, BK = 64, HALF = 128, HTB = HALF * BK * 2, NXCD = 8, WGM = 8;
DI int lds_byte(int r, int c) { const int st = (r >> 4) * 2 + (c >> 5), rr = r & 15, cc = c & 31, ob = rr * 64 + cc * 2; return st * 1024 + (ob ^ (((ob >> 9) & 1) << 5)); }
DI void stage_rc(int b, int& R, int& C) { const int st = b / 1024, sb = b % 1024, swz = sb ^ (((sb >> 9) & 1) << 5); R = (st >> 1) * 16 + swz / 64; C = (st & 1) * 32 + (swz % 64) / 2; }
DI int perm32(int rho) { const int n = rho >> 4, i = rho & 15; return 8 * (i >> 2) + 4 * n + (i & 3); }
struct Unit { int pm, pn; };
struct Gemm { const bf16_t* A; const bf16_t* Bt; int M, N, K; };
struct StaticOrder {
    int nM, nN, nwg, G, c, extra;
    DI void init(int M, int N, int G_, int c_, int extra_) { nM = M / BM; nN = N / BM; nwg = nM * nN; G = G_; c = c_; extra = extra_; }
    DI bool next(int i, Unit& u) const {
        const long L = (long)i * G + c; if (L >= nwg + extra) return false;
        if (L >= nwg) { const int q = (int)(L - nwg); u.pm = nM + (q >> 2); u.pn = nN + q; return true; }
        int wgid = (int)L; { const int q = nwg / NXCD, r = nwg % NXCD, xcd = wgid % NXCD, off = wgid / NXCD; wgid = (xcd < r ? xcd * (q + 1) : r * (q + 1) + (xcd - r) * q) + off; }
        const int nig = WGM * nN, gid = wgid / nig, fm = gid * WGM, gsz = (nM - fm) < WGM ? (nM - fm) : WGM;
        u.pm = fm + ((wgid % nig) % gsz); u.pn = (wgid % nig) / gsz; return true;
    }
};

template <class Epi>
DI void gemm_phase(LAS uchar* lds, const Gemm g, const StaticOrder& S, const Epi& E) {
    const int tid = otid(), wid = __builtin_amdgcn_readfirstlane(tid >> 6), lane = tid & 63, wr = wid >> 2, wc = wid & 3, fr = lane & 15, fq = lane >> 4;
    const int K = g.K, nt = K / BK;
    unsigned voffA[2], voffB[2];
#pragma unroll
    for (int i = 0; i < 2; ++i) { int R, C; stage_rc(tid * 16 + i * 8192, R, C); const int Rb = Epi::PERM ? ((R & ~31) + perm32(R & 31)) : R;
        voffA[i] = (unsigned)(R * K + C) * 2u; voffB[i] = (unsigned)(Rb * K + C) * 2u; }
    const size_t kstep = (size_t)(BK * 2);
    const size_t hstep = (size_t)HALF * K * 2;
    const size_t tstep = 2 * hstep;
    const unsigned ldsw = (unsigned)wid * 1024u;
    const int aoff = lds_byte(wr * 64 + fr, fq * 8), boff = lds_byte(wc * 32 + fr, fq * 8);
#define PG8_SA(b, h) (((b) * 2 + (h)) * HTB)
#define PG8_SB(b, h) ((4 + (b) * 2 + (h)) * HTB)
#define PG8_STAGE(bufoff, gbase, voff) do { _Pragma("unroll") for (int _i = 0; _i < 2; ++_i) \
        __builtin_amdgcn_global_load_lds((const unsigned*)((const char*)(gbase) + (voff)[_i]), (LAS unsigned*)(lds + (bufoff) + ldsw + _i * 8192), 16, 0, 0); } while (0)
#define PG8_LDA(dst, b, h) do { _Pragma("unroll") for (int m = 0; m < 4; ++m) _Pragma("unroll") for (int k = 0; k < 2; ++k) dst[m][k] = *(const LAS bf16x8*)(lds + PG8_SA(b, h) + aoff + m * 2048 + k * 1024); } while (0)
#define PG8_LDB(dst, b, h) do { _Pragma("unroll") for (int n = 0; n < 2; ++n) _Pragma("unroll") for (int k = 0; k < 2; ++k) dst[n][k] = *(const LAS bf16x8*)(lds + PG8_SB(b, h) + boff + n * 2048 + k * 1024); } while (0)
#define PG8_MMA(ai, bj, At, Bt) do { __builtin_amdgcn_s_setprio(1); _Pragma("unroll") for (int m = 0; m < 4; ++m) _Pragma("unroll") for (int n = 0; n < 2; ++n) _Pragma("unroll") for (int k = 0; k < 2; ++k) \
        acc[ai][bj][m][n] = __builtin_amdgcn_mfma_f32_16x16x32_bf16(Bt[n][k], At[m][k], acc[ai][bj][m][n], 0, 0, 0); __builtin_amdgcn_s_setprio(0); } while (0)
#define PG8_WAIT_V(n) asm volatile("s_waitcnt vmcnt(" #n ")" ::: "memory")
#define PG8_WAIT_L(n) asm volatile("s_waitcnt lgkmcnt(" #n ")" ::: "memory")
#define PG8_BAR __builtin_amdgcn_s_barrier()
#define PG8_SCHED __builtin_amdgcn_sched_barrier(0)
    Unit cur, nxt; int ui = 0;
    if (!S.next(0, cur)) return;
    f32x4 acc[2][2][4][2];
#pragma unroll
    for (int a = 0; a < 2; ++a)
#pragma unroll
        for (int b = 0; b < 2; ++b)
#pragma unroll
            for (int m = 0; m < 4; ++m)
#pragma unroll
                for (int n = 0; n < 2; ++n) acc[a][b][m][n] = (f32x4){0.f, 0.f, 0.f, 0.f};
    bf16x8 At[4][2], B0[2][2], B1[2][2];
    const char* cA = (const char*)g.A + (size_t)cur.pm * tstep; const char* cB = (const char*)g.Bt + (size_t)cur.pn * tstep;
    PG8_STAGE(PG8_SB(0, 0), cB, voffB); PG8_STAGE(PG8_SA(0, 0), cA, voffA); PG8_STAGE(PG8_SB(0, 1), cB + hstep, voffB); PG8_STAGE(PG8_SA(0, 1), cA + hstep, voffA);
    if (wr == 1) PG8_BAR;
    PG8_WAIT_V(4); PG8_BAR;
    PG8_STAGE(PG8_SB(1, 0), cB + kstep, voffB); PG8_STAGE(PG8_SA(1, 0), cA + kstep, voffA); PG8_STAGE(PG8_SB(1, 1), cB + hstep + kstep, voffB);
    PG8_WAIT_V(6); PG8_BAR;
    for (;;) {
        const bool has_next = S.next(ui + 1, nxt);
        const char* nA = has_next ? (const char*)g.A + (size_t)nxt.pm * tstep : cA; const char* nB = has_next ? (const char*)g.Bt + (size_t)nxt.pn * tstep : cB;
        for (int t = 0; t < nt; t += 2) {
            const bool last = (t == nt - 2);
            const char* a1 = cA + (size_t)(t + 1) * kstep;
            const char* a2 = last ? nA : cA + (size_t)(t + 2) * kstep; const char* b2 = last ? nB : cB + (size_t)(t + 2) * kstep;
            const char* a3 = a2 + kstep; const char* b3 = b2 + kstep;
            PG8_LDB(B0, 0, 0); PG8_SCHED; PG8_LDA(At, 0, 0); PG8_STAGE(PG8_SA(1, 1), a1 + hstep, voffA);
            PG8_WAIT_L(8); PG8_BAR; PG8_WAIT_L(0); PG8_MMA(0, 0, At, B0); PG8_BAR; PG8_SCHED;
            PG8_LDB(B1, 0, 1); PG8_STAGE(PG8_SB(0, 0), b2, voffB);
            PG8_BAR; PG8_WAIT_L(0); PG8_MMA(0, 1, At, B1); PG8_BAR;
            PG8_LDA(At, 0, 1); PG8_STAGE(PG8_SA(0, 0), a2, voffA);
            PG8_BAR; PG8_WAIT_L(0); PG8_MMA(1, 0, At, B0); PG8_BAR; PG8_SCHED;
            PG8_STAGE(PG8_SB(0, 1), b2 + hstep, voffB);
            PG8_WAIT_V(6); PG8_BAR; PG8_MMA(1, 1, At, B1); PG8_BAR;
            PG8_LDB(B0, 1, 0); PG8_SCHED; PG8_LDA(At, 1, 0); PG8_STAGE(PG8_SA(0, 1), a2 + hstep, voffA);
            PG8_WAIT_L(8); PG8_BAR; PG8_WAIT_L(0); PG8_MMA(0, 0, At, B0); PG8_BAR; PG8_SCHED;
            PG8_LDB(B1, 1, 1); PG8_STAGE(PG8_SB(1, 0), b3, voffB);
            PG8_BAR; PG8_WAIT_L(0); PG8_MMA(0, 1, At, B1); PG8_BAR;
            PG8_LDA(At, 1, 1); PG8_STAGE(PG8_SA(1, 0), a3, voffA);
            PG8_BAR; PG8_WAIT_L(0); PG8_MMA(1, 0, At, B0); PG8_BAR; PG8_SCHED;
            PG8_STAGE(PG8_SB(1, 1), b3 + hstep, voffB);
            PG8_WAIT_V(6); PG8_BAR; PG8_MMA(1, 1, At, B1); PG8_BAR;
        }
        E(acc, cur, wr, wc, fr, fq);
        if (!has_next) break;
#pragma unroll
        for (int a = 0; a < 2; ++a)
#pragma unroll
            for (int b = 0; b < 2; ++b)
#pragma unroll
                for (int m = 0; m < 4; ++m)
#pragma unroll
                    for (int n = 0; n < 2; ++n) acc[a][b][m][n] = (f32x4){0.f, 0.f, 0.f, 0.f};
        cur = nxt; cA = nA; cB = nB; ++ui;
    }
    PG8_WAIT_V(0);
    if (wr == 0) PG8_BAR;
    PG8_BAR;
#undef PG8_SA
#undef PG8_SB
#undef PG8_STAGE
#undef PG8_LDA
#undef PG8_LDB
#undef PG8_MMA
#undef PG8_WAIT_V
#undef PG8_WAIT_L
#undef PG8_BAR
#undef PG8_SCHED
}
}
using pg8::Unit;

struct EpiF32 {
    static constexpr bool PERM = false;
    float* C; int ldc;
    DI void operator()(const f32x4 (&acc)[2][2][4][2], const Unit& u, int wr, int wc, int fr, int fq) const {
        const int row0 = u.pm * 256 + wr * 64 + fr, col0 = u.pn * 256 + wc * 32 + 4 * fq;
#pragma unroll
        for (int ai = 0; ai < 2; ++ai)
#pragma unroll
            for (int m = 0; m < 4; ++m) { float* rowp = C + (size_t)(row0 + ai * 128 + m * 16) * ldc + col0;
#pragma unroll
                for (int bj = 0; bj < 2; ++bj)
#pragma unroll
                    for (int n = 0; n < 2; ++n) *(f32x4*)(rowp + bj * 128 + n * 16) = acc[ai][bj][m][n]; }
    }
};

struct EpiO {
    static constexpr bool PERM = true;
    bf16_t* C;
    DI void operator()(const f32x4 (&acc)[2][2][4][2], const Unit& u, int wr, int wc, int fr, int fq) const {
        asm volatile("" : "+v"(fr), "+v"(fq));
        const int row0 = u.pm * 256 + wr * 64 + fr, col0 = u.pn * 256 + wc * 32 + 8 * fq;
#pragma unroll
        for (int ai = 0; ai < 2; ++ai)
#pragma unroll
            for (int m = 0; m < 4; ++m) { bf16_t* rowp = C + (size_t)(row0 + ai * 128 + m * 16) * 2048 + col0;
#pragma unroll
                for (int bj = 0; bj < 2; ++bj) { const f32x4 v0 = acc[ai][bj][m][0], v1 = acc[ai][bj][m][1];
                    *(u32x4*)(rowp + bj * 128) = (u32x4){pk_bf16(v0[0], v0[1]), pk_bf16(v0[2], v0[3]), pk_bf16(v1[0], v1[1]), pk_bf16(v1[2], v1[3])}; } }
    }
};

struct Epi1 {
    static constexpr bool PERM = true;
    bf16_t* P0; bf16_t* memkv; float* out; const float *tAc, *tAs, *tBc, *tBs; bf16_t *kfd, *kfr, *kfm;
    template <int TYPE>
    DI void body(const f32x4 (&acc)[2][2][4][2], const Unit& u, int wr, int wc, int fr, int fq) const {
        const int hp0 = wc * 32 + fq * 8;
#pragma unroll
        for (int ai = 0; ai < 2; ++ai)
#pragma unroll
            for (int m = 0; m < 4; ++m) {
                const int r = u.pm * 256 + ai * 128 + wr * 64 + m * 16 + fr;
                f32x4 cs = {1.f, 1.f, 1.f, 1.f}, sn = {0.f, 0.f, 0.f, 0.f};
                bool rot = false;
                if (TYPE == 0 || TYPE == 1) { cs = *(const f32x4*)(tAc + (size_t)r * 64 + (hp0 >> 1)); sn = *(const f32x4*)(tAs + (size_t)r * 64 + (hp0 >> 1)); rot = true; }
                if ((TYPE == 4 || TYPE == 5) && wc == 0) { cs = *(const f32x4*)(tBc + (size_t)r * 16 + (hp0 >> 1)); sn = *(const f32x4*)(tBs + (size_t)r * 16 + (hp0 >> 1)); rot = true; }
#pragma unroll
                for (int bj = 0; bj < 2; ++bj) {
                    f32x4 v0 = acc[ai][bj][m][0], v1 = acc[ai][bj][m][1];
                    if (TYPE == 0 || TYPE == 1 || TYPE == 4 || TYPE == 5) {
                        if (rot) {
                            f32x4 o0 = {v0[0] * cs[0] - v0[1] * sn[0], v0[1] * cs[0] + v0[0] * sn[0], v0[2] * cs[1] - v0[3] * sn[1], v0[3] * cs[1] + v0[2] * sn[1]};
                            f32x4 o1 = {v1[0] * cs[2] - v1[1] * sn[2], v1[1] * cs[2] + v1[0] * sn[2], v1[2] * cs[3] - v1[3] * sn[3], v1[3] * cs[3] + v1[2] * sn[3]};
                            v0 = o0; v1 = o1;
                        }
                        if (TYPE == 1 || TYPE == 4) { v0 *= RSQ128; v1 *= RSQ128; }
                    }
                    if (TYPE == 3) { for (int j = 0; j < 4; ++j) { v0[j] = silu_f(v0[j]); v1[j] = silu_f(v1[j]); } }
                    if (TYPE == 7) { v0 *= RSQ128; v1 *= RSQ128; }
                    u32x4 w = {pk_bf16(v0[0], v0[1]), pk_bf16(v0[2], v0[3]), pk_bf16(v1[0], v1[1]), pk_bf16(v1[2], v1[3])};
                    *(u32x4*)(P0 + (size_t)r * LD0 + u.pn * 256 + bj * 128 + hp0) = w;
                    if ((TYPE == 1 || TYPE == 5) && r < TP) {
                        const unsigned kh = (unsigned)((hp0 >> 4) * 512 + ((hp0 >> 3) & 1) * 256);
                        if (TYPE == 1) { const unsigned hd = (unsigned)((u.pn - 4) * 2 + bj);
                            *(u32x4*)(kfr + (hd * 1048576u + (unsigned)(r >> 5) * 4096u + kh + (unsigned)(r & 31) * 8u)) = w; }
                        else { const unsigned hd = (unsigned)((u.pn - 28) * 2 + bj);
#pragma unroll
                            for (int b = 0; b < 3; ++b) { const int sh = 2 * b; const unsigned L = (unsigned)r >> sh, res = (unsigned)r & ((1u << sh) - 1u);
                                *(u32x4*)(kfd + ((unsigned)b * 8388608u + hd * 1048576u + (res * (256u >> sh) + (L >> 5)) * 4096u + kh + (L & 31u) * 8u)) = w; } }
                    }
                    if (TYPE == 5 || TYPE == 6) {
                        float* dstrow = nullptr;
                        if (r >= 6144 && r < 8192) dstrow = out + (TYPE == 5 ? O_PSWAK : O_PSWAV) + (size_t)(r - 6144) * 1024;
                        else if (r >= 8192 && r < NROW) dstrow = out + (TYPE == 5 ? O_SSWAK : O_SSWAV) + (size_t)(r - 8192) * 1024;
                        if (dstrow) {
                            const int hd = (u.pn - (TYPE == 5 ? 28 : 32)) * 2 + bj; float* d = dstrow + hd * 128;
                            if (TYPE == 5 && wc == 0) { const int i0 = hp0 >> 1;
                                *(f32x4*)(d + i0) = (f32x4){v0[0], v0[2], v1[0], v1[2]}; *(f32x4*)(d + 16 + i0) = (f32x4){v0[1], v0[3], v1[1], v1[3]}; }
                            else { *(f32x4*)(d + hp0) = v0; *(f32x4*)(d + hp0 + 4) = v1; }
                        }
                    }
                }
            }
    }
    DI void operator()(const f32x4 (&acc)[2][2][4][2], const Unit& u, int wr, int wc, int fr, int fq) const {
        asm volatile("" : "+v"(fr), "+v"(fq));
        if (u.pm >= 33) {
            const int layer = u.pm - 33, cn0 = (u.pn - 44 - 4 * layer) * 256, hp0 = wc * 32 + fq * 8;
#pragma unroll
            for (int ai = 0; ai < 2; ++ai)
#pragma unroll
                for (int m = 0; m < 4; ++m) { const int rl = ai * 128 + wr * 64 + m * 16 + fr;
#pragma unroll
                    for (int bj = 0; bj < 2; ++bj) { const f32x4 v0 = acc[ai][bj][m][0], v1 = acc[ai][bj][m][1]; const int col = cn0 + bj * 128 + hp0;
                        u32x4 w = {pk_bf16(v0[0], v0[1]), pk_bf16(v0[2], v0[3]), pk_bf16(v1[0], v1[1]), pk_bf16(v1[2], v1[3])};
                        *(u32x4*)(memkv + (size_t)(layer * 256 + rl) * 1024 + col) = w;
                        if (col < 512) { const int hd = col >> 7, hq = col & 127, ks = hq >> 4, hl = (hq >> 3) & 1;
                            *(u32x4*)(kfm + ((((size_t)(layer * 4 + hd) * 8 + (rl >> 5)) * 8 + ks) * 64 + hl * 32 + (rl & 31)) * 8) = w; }
                        float* d = out + (col < 512 ? O_PMEMK : O_PMEMV) + (size_t)(layer * 256 + rl) * 512 + (col & 511);
                        *(f32x4*)d = v0; *(f32x4*)(d + 4) = v1; } }
            return;
        }
        const int pn = u.pn;
        if (pn < 4) body<0>(acc, u, wr, wc, fr, fq); else if (pn < 8) body<1>(acc, u, wr, wc, fr, fq); else if (pn < 16) body<2>(acc, u, wr, wc, fr, fq);
        else if (pn < 24) body<3>(acc, u, wr, wc, fr, fq); else if (pn < 28) body<4>(acc, u, wr, wc, fr, fq); else if (pn < 32) body<5>(acc, u, wr, wc, fr, fq);
        else if (pn < 36) body<6>(acc, u, wr, wc, fr, fq); else if (pn < 40) body<3>(acc, u, wr, wc, fr, fq); else if (pn < 42) body<7>(acc, u, wr, wc, fr, fq);
        else body<3>(acc, u, wr, wc, fr, fq);
    }
};

struct Epi3 {
    static constexpr bool PERM = true;
    bf16_t* P1; float* lns;
    template <int TYPE>
    DI void body(const f32x4 (&acc)[2][2][4][2], const Unit& u, int wr, int wc, int fr, int fq) const {
        const int hp0 = wc * 32 + fq * 8;
#pragma unroll
        for (int ai = 0; ai < 2; ++ai)
#pragma unroll
            for (int m = 0; m < 4; ++m) {
                const int r = u.pm * 256 + ai * 128 + wr * 64 + m * 16 + fr;
                float s1 = 0.f, s2 = 0.f;
#pragma unroll
                for (int bj = 0; bj < 2; ++bj) {
                    f32x4 v0 = acc[ai][bj][m][0], v1 = acc[ai][bj][m][1];
#pragma unroll
                    for (int j = 0; j < 4; ++j) {
                        if (TYPE <= 1) { v0[j] = gelu_f(v0[j]); v1[j] = gelu_f(v1[j]); }
                        if (TYPE == 2) { v0[j] = silu_f(v0[j]); v1[j] = silu_f(v1[j]); }
                        if (TYPE == 3) { v0[j] *= RSQ128; v1[j] *= RSQ128; }
                        if (TYPE == 1) { s1 += v0[j] + v1[j]; s2 += v0[j] * v0[j] + v1[j] * v1[j]; }
                    }
                    u32x4 w = {pk_bf16(v0[0], v0[1]), pk_bf16(v0[2], v0[3]), pk_bf16(v1[0], v1[1]), pk_bf16(v1[2], v1[3])};
                    *(u32x4*)(P1 + (size_t)r * LD1 + u.pn * 256 + bj * 128 + hp0) = w;
                }
                if (TYPE == 1) {
                    s1 += __shfl_xor(s1, 16); s2 += __shfl_xor(s2, 16); s1 += __shfl_xor(s1, 32); s2 += __shfl_xor(s2, 32);
                    if (fq == 0) { atomicAdd(lns + 2 * r, s1); atomicAdd(lns + 2 * r + 1, s2); }
                }
            }
    }
    DI void operator()(const f32x4 (&acc)[2][2][4][2], const Unit& u, int wr, int wc, int fr, int fq) const {
        asm volatile("" : "+v"(fr), "+v"(fq));
        const int pn = u.pn;
        if (pn < 8) body<0>(acc, u, wr, wc, fr, fq); else if (pn < 16) body<1>(acc, u, wr, wc, fr, fq); else if (pn < 24) body<2>(acc, u, wr, wc, fr, fq);
        else if (pn < 26) body<3>(acc, u, wr, wc, fr, fq); else body<2>(acc, u, wr, wc, fr, fq);
    }
};

DI int orig_col(int p, int mode) {
    if (mode == 1) {
        const int hp = p & 127, base = p & ~127;
        if (p < 2048) return base + (hp >> 1) + 64 * (hp & 1);
        if (p >= 6144 && p < 8192 && hp < 32) return base + (hp >> 1) + 16 * (hp & 1);
    }
    return p;
}

DI void wconv(const Params& p, LAS uchar* lds, int t_begin, int t_end, int start, int stride) {
    const int tid = otid();
    bf16_t* WT1 = (bf16_t*)(p.ws + W_WT1);
    LAS float* tl = (LAS float*)lds;
    {
        struct WT { const float* src; bf16_t* dst; int K, N, mode, kt, pt; };
        auto decode = [&](int t) { WT r; int tt = t; r.mode = 0;
            if (tt < 2816) { r.src = p.w_in_even; r.dst = WT1; r.K = 2048; r.N = 11264; r.mode = 1; }
            else if ((tt -= 2816) < 896) { r.src = p.w_out_even; r.dst = (bf16_t*)(p.ws + W_WT2); r.K = 3584; r.N = 2048; }
            else if ((tt -= 896) < 1792) { r.src = p.w_in_odd; r.dst = (bf16_t*)(p.ws + W_WT3); r.K = 2048; r.N = 7168; }
            else if ((tt -= 1792) < 640) { r.src = p.w_out_odd; r.dst = (bf16_t*)(p.ws + W_WT4); r.K = 2560; r.N = 2048; }
            else { tt -= 640; const int which = tt >> 7; tt &= 127;
                r.src = ((which & 1) ? p.w_mem_v : p.w_mem_k) + (size_t)(which >> 1) * 2048 * 512; r.dst = WT1 + (size_t)(11264 + which * 512) * 2048; r.K = 2048; r.N = 512; }
            const int nkt = r.K / 64; r.kt = tt % nkt; r.pt = tt / nkt; return r; };
        auto loadt = [&](const WT& r, f32x4 (&v)[4]) {
#pragma unroll
            for (int i = 0; i < 4; ++i) { const int f = tid + 512 * i, row = f >> 5, c4 = f & 31; v[i] = *(const f32x4*)(r.src + (size_t)(r.kt * 64 + row) * r.N + r.pt * 128 + c4 * 4); } };
        f32x4 cur[4], nxt[4], nx2[4];
        const int t0 = t_begin + start;
        if (t0 < t_end) { const WT r0 = decode(t0); loadt(r0, cur); }
        if (t0 + stride < t_end) { const WT r1 = decode(t0 + stride); loadt(r1, nxt); }
        for (int t = t0; t < t_end; t += stride) {
            const WT r = decode(t);
            if (t + 2 * stride < t_end) { const WT rn = decode(t + 2 * stride); loadt(rn, nx2); }
            const int c0 = r.pt * 128; const int pc = r.mode == 1 ? (c0 < 2048 ? 1 : ((c0 >= 6144 && c0 < 8192) ? 2 : 0)) : 0;
#pragma unroll
            for (int i = 0; i < 4; ++i) { const int f = tid + 512 * i, row = f >> 5, c4 = f & 31;
#pragma unroll
                for (int j = 0; j < 4; ++j) { const int d = c4 * 4 + j; const int pp = pc == 1 ? 2 * (d & 63) + (d >> 6) : ((pc == 2 && d < 32) ? 2 * (d & 15) + (d >> 4) : d); tl[row * 129 + pp] = cur[i][j]; } }
            __syncthreads();
#pragma unroll
            for (int i = 0; i < 2; ++i) { const int piece = tid + 512 * i, pp = piece >> 3, kc = piece & 7; float v[8];
#pragma unroll
                for (int j = 0; j < 8; ++j) v[j] = tl[(kc * 8 + j) * 129 + pp];
                u32x4 wv = {pk_bf16(v[0], v[1]), pk_bf16(v[2], v[3]), pk_bf16(v[4], v[5]), pk_bf16(v[6], v[7])};
                *(u32x4*)(r.dst + (size_t)(r.pt * 128 + pp) * r.K + r.kt * 64 + kc * 8) = wv; }
            __syncthreads();
#pragma unroll
            for (int i = 0; i < 4; ++i) { cur[i] = nxt[i]; nxt[i] = nx2[i]; }
        }
    }
}

DI void phase0(const Params& p, LAS uchar* lds) {
    const int tid = otid(), wid = tid >> 6, lane = tid & 63, G = gridDim.x, B = blockIdx.x;
    bf16_t* WT1 = (bf16_t*)(p.ws + W_WT1);
    LAS float* tl = (LAS float*)lds;
    wconv(p, lds, 0, 2816, B, G); wconv(p, lds, 6144, 6656, B, G);
    bf16_t* A0 = (bf16_t*)(p.ws + W_A0);
    for (int row = B * 8 + wid; row < 8960; row += G * 8) {
        bf16_t* dst = A0 + (size_t)row * 2048;
        if (row >= NROW && row < MPAD) { for (int i = 0; i < 8; ++i) *(u32x2*)(dst + (i * 64 + lane) * 4) = (u32x2){0u, 0u}; continue; }
        const float* src; const float* g;
        if (row < TP) { src = p.x_prompt + (size_t)row * 2048; g = p.pre_norm; }
        else if (row < NROW) { src = p.x_sample + (size_t)(row - TP) * 2048; g = p.pre_norm; }
        else { const int q = row - MPAD; src = p.mem_prompt + (size_t)(q & 255) * 2048; g = p.mem_norm + (q >> 8) * 2048; }
        f32x4 v[8]; float ss = 0.f;
#pragma unroll
        for (int i = 0; i < 8; ++i) { v[i] = *(const f32x4*)(src + (i * 64 + lane) * 4); ss += v[i][0] * v[i][0] + v[i][1] * v[i][1] + v[i][2] * v[i][2] + v[i][3] * v[i][3]; }
        ss = wave_sum(ss); const float rs = rsqrtf(ss * (1.f / 2048.f) + 1e-6f);
#pragma unroll
        for (int i = 0; i < 8; ++i) { const f32x4 gg = *(const f32x4*)(g + (i * 64 + lane) * 4);
            *(u32x2*)(dst + (i * 64 + lane) * 4) = (u32x2){pk_bf16(v[i][0] * rs * gg[0], v[i][1] * rs * gg[1]), pk_bf16(v[i][2] * rs * gg[2], v[i][3] * rs * gg[3])}; }
    }
    float* tAc = (float*)(p.ws + W_TAC); float* tAs = (float*)(p.ws + W_TAS); float* tBc = (float*)(p.ws + W_TBC); float* tBs = (float*)(p.ws + W_TBS);
    for (int idx = B * 512 + tid; idx < MPAD * 80; idx += G * 512) {
        const int row = idx / 80, e = idx - row * 80;
        const int pos = row < TP ? row : (row < NROW ? TP + ((row - TP) & 3) : 0);
        if (e < 64) { const float inv = 1.0f / powf(10000.0f, (float)e * (1.f / 64.f)); const float ang = (float)pos * inv; tAc[row * 64 + e] = cosf(ang); tAs[row * 64 + e] = sinf(ang); }
        else { const int i = e - 64; const float inv = 1.0f / powf(500000.0f, (float)i * (1.f / 16.f)); const float ang = (float)pos * inv; tBc[row * 16 + i] = cosf(ang); tBs[row * 16 + i] = sinf(ang); }
    }
    bf16_t* WC = (bf16_t*)(p.ws + W_WC);
    for (int idx = B * 512 + tid; idx < 16 * 128 * 128; idx += G * 512) { const int s = idx & 127, t = (idx >> 7) & 127; WC[idx] = f2bf(s <= t ? p.w_spatial[idx] : 0.f); }
    float* lns = (float*)(p.ws + W_LNS);
    for (int idx = B * 512 + tid; idx < MPAD * 2; idx += G * 512) lns[idx] = 0.f;
}

DI void load_kfm(bf16x8 (&kf)[8], const bf16_t* chunk, int lane) {
#pragma unroll
    for (int ks = 0; ks < 8; ++ks) kf[ks] = *(const bf16x8*)(chunk + (size_t)(ks * 64 + lane) * 8);
}
DI void load_kf(bf16x8 (&kf)[8], const bf16_t* kp) {
#pragma unroll
    for (int ks = 0; ks < 8; ++ks) kf[ks] = *(const bf16x8*)(kp + 16 * ks);
}
DI void flash_chunk(const bf16x8 (&qf)[8], const bf16x8 (&kf)[8], int maskmode, LAS uchar* vbase, int RS, int lrow0, int lane, float& m, float& l, f32x16 (&O)[4]) {
    const int rl = lane & 31, h = lane >> 5;
    f32x16 s; for (int i = 0; i < 16; ++i) s[i] = 0.f;
#pragma unroll
    for (int ks = 0; ks < 8; ++ks) s = MFMA32(kf[ks], qf[ks], s);
    if (maskmode != 0) {
        const int mlo = maskmode == 2 ? 0 : -64, mhi = maskmode == 1 ? 0 : 64;
#pragma unroll
        for (int i = 0; i < 16; ++i) { const int dd = rl - crow(i, h); s[i] = ((dd >= mlo) & (dd <= mhi)) ? s[i] : -1e30f; }
    }
    float mx = s[0];
#pragma unroll
    for (int i = 1; i < 16; ++i) mx = fmaxf(mx, s[i]);
    mx = fmaxf(mx, __shfl_xor(mx, 32));
    const float mn = fmaxf(m, mx), alpha = __builtin_amdgcn_exp2f((m - mn) * 1.4426950408889634f), nm = -mn * 1.4426950408889634f; m = mn;
    float ls = 0.f;
#pragma unroll
    for (int i = 0; i < 16; ++i) { s[i] = __builtin_amdgcn_exp2f(fmaf(s[i], 1.4426950408889634f, nm)); ls += s[i]; }
    l = l * alpha + ls;
#pragma unroll
    for (int dt = 0; dt < 4; ++dt) O[dt] *= alpha;
    const bf16x8 pf0 = pack8(s[0], s[1], s[2], s[3], s[4], s[5], s[6], s[7]), pf1 = pack8(s[8], s[9], s[10], s[11], s[12], s[13], s[14], s[15]);
#pragma unroll
    for (int dt = 0; dt < 4; ++dt) {
        const bf16x8 v0 = tr_frag(vbase, RS, lrow0 + 4 * h, lrow0 + 8 + 4 * h, 32 * dt, lane);
        O[dt] = MFMA32(v0, pf0, O[dt]);
        const bf16x8 v1 = tr_frag(vbase, RS, lrow0 + 16 + 4 * h, lrow0 + 24 + 4 * h, 32 * dt, lane);
        O[dt] = MFMA32(v1, pf1, O[dt]);
    }
}

DI void dil_tile(const Params& p, int item, LAS uchar* lds) {
    const int tid = otid(), w = tid >> 6, lane = tid & 63, rl = lane & 31, h = lane >> 5;
    const bf16_t* P0 = (const bf16_t*)(p.ws + W_P0);
    const int branch = item >> 8, rem = item & 255, hd = rem & 7, tb = rem >> 3;
    const int r = branch == 0 ? 1 : (branch == 1 ? 4 : 16), ppr = 32 / r, res = tb / ppr, n0 = 2 * (tb % ppr);
    const int RS = 320;
#pragma unroll
    for (int i = 0; i < 12; ++i) { const int piece = tid + 512 * i, row = piece >> 4, c16 = piece & 15; const int Lk = (n0 - 1) * 128 + row;
        if (Lk >= 0) { const size_t pos = (size_t)Lk * r + res; *(LAS u32x4*)(lds + row * RS + c16 * 16) = *(const u32x4*)(P0 + pos * LD0 + 8192 + hd * 128 + c16 * 8); } }
    const int Lq = n0 * 128 + 32 * w + rl; const size_t posq = (size_t)Lq * r + res;
    bf16x8 qf[8];
#pragma unroll
    for (int ks = 0; ks < 8; ++ks) qf[ks] = *(const bf16x8*)(P0 + posq * LD0 + 6144 + hd * 128 + 16 * ks + 8 * h);
    const int c0 = n0 > 0 ? 0 : (4 - w > 0 ? 4 - w : 0);
    const bf16_t* KFD = (const bf16_t*)(p.ws + W_KFD) + (size_t)branch * 8192 * 1024 + ((size_t)(hd * r + res) * (256 / r)) * 4096;
    auto kptr = [&](int c) { const int Lk0 = n0 * 128 + 32 * w - 128 + 32 * c; return KFD + (size_t)(Lk0 >> 5) * 4096; };
    bf16x8 kfA[8], kfB[8];
    load_kfm(kfA, kptr(c0), lane);
    __syncthreads();
    f32x16 O[4]; for (int dt = 0; dt < 4; ++dt) for (int i = 0; i < 16; ++i) O[dt][i] = 0.f;
    float m = -1e30f, l = 0.f;
    for (int c = c0;;) {
        load_kfm(kfB, kptr(c < 4 ? c + 1 : 4), lane); __builtin_amdgcn_sched_barrier(0);
        flash_chunk(qf, kfA, c == 0 ? 1 : (c == 4 ? 2 : 0), lds, RS, 32 * w + 32 * c, lane, m, l, O);
        if (++c >= 5) break;
        load_kfm(kfA, kptr(c < 4 ? c + 1 : 4), lane); __builtin_amdgcn_sched_barrier(0);
        flash_chunk(qf, kfB, c == 0 ? 1 : (c == 4 ? 2 : 0), lds, RS, 32 * w + 32 * c, lane, m, l, O);
        if (++c >= 5) break;
    }
    l += __shfl_xor(l, 32);
    const float inv = 1.f / l;
    bf16_t* DO = (bf16_t*)(p.ws + W_DILO) + ((size_t)branch * 8192 + posq) * 1024 + hd * 128;
#pragma unroll
    for (int dt = 0; dt < 4; ++dt)
#pragma unroll
        for (int g4 = 0; g4 < 4; ++g4) { const int d0 = 32 * dt + 8 * g4 + 4 * h;
            *(u32x2*)(DO + d0) = (u32x2){pk_bf16(O[dt][4 * g4] * inv, O[dt][4 * g4 + 1] * inv), pk_bf16(O[dt][4 * g4 + 2] * inv, O[dt][4 * g4 + 3] * inv)}; }
    if (h == 0) { ((float*)(p.ws + W_DILM))[((size_t)branch * 8192 + posq) * 8 + hd] = m; ((float*)(p.ws + W_DILL))[((size_t)branch * 8192 + posq) * 8 + hd] = l; }
    __syncthreads();
}

DI void memp_tile(const Params& p, int item, int layer, LAS uchar* lds) {
    const int tid = otid(), w = tid >> 6, lane = tid & 63, rl = lane & 31, h = lane >> 5;
    const bf16_t* PX = (const bf16_t*)(p.ws + (layer ? W_P1 : W_P0)); const int ld = layer ? LD1 : LD0, qcol = layer ? 6144 : 10240, gcol = layer ? 6656 : 10752;
    bf16_t* CAT = (bf16_t*)(p.ws + (layer ? W_CAT1 : W_CAT0)); const int ldc = layer ? LDC1 : LDC0, ccol = layer ? 2048 : 3072;
    const bf16_t* MKV = (const bf16_t*)(p.ws + W_MEMKV) + (size_t)layer * 256 * 1024;
    const int qt = item >> 2, hd = item & 3; const int RS = 320;
#pragma unroll
    for (int i = 0; i < 8; ++i) { const int piece = tid + 512 * i, row = piece >> 4, c16 = piece & 15;
        *(LAS u32x4*)(lds + row * RS + c16 * 16) = *(const u32x4*)(MKV + (size_t)row * 1024 + 512 + hd * 128 + c16 * 8); }
    const size_t posq = (size_t)qt * 256 + 32 * w + rl;
    bf16x8 qf[8];
#pragma unroll
    for (int ks = 0; ks < 8; ++ks) qf[ks] = *(const bf16x8*)(PX + posq * ld + qcol + hd * 128 + 16 * ks + 8 * h);
    bf16x8 kfA[8], kfB[8];
    const bf16_t* KFM = (const bf16_t*)(p.ws + W_KFM) + (size_t)(layer * 4 + hd) * 8 * 4096;
    load_kfm(kfA, KFM, lane);
    __syncthreads();
    f32x16 O[4]; for (int dt = 0; dt < 4; ++dt) for (int i = 0; i < 16; ++i) O[dt][i] = 0.f;
    float m = -1e30f, l = 0.f;
    for (int c = 0; c < 8; c += 2) {
        load_kfm(kfB, KFM + (size_t)(c + 1) * 4096, lane); __builtin_amdgcn_sched_barrier(0);
        flash_chunk(qf, kfA, 0, lds, RS, 32 * c, lane, m, l, O);
        load_kfm(kfA, KFM + (size_t)(c < 6 ? c + 2 : 7) * 4096, lane); __builtin_amdgcn_sched_barrier(0);
        flash_chunk(qf, kfB, 0, lds, RS, 32 * (c + 1), lane, m, l, O);
    }
    l += __shfl_xor(l, 32);
    const float inv = 1.f / l;
#pragma unroll
    for (int dt = 0; dt < 4; ++dt)
#pragma unroll
        for (int g4 = 0; g4 < 4; ++g4) { const int d0 = 32 * dt + 8 * g4 + 4 * h;
            const u32x2 gt = *(const u32x2*)(PX + posq * ld + gcol + hd * 128 + d0);
            *(u32x2*)(CAT + posq * ldc + ccol + hd * 128 + d0) = (u32x2){pk_bf16(O[dt][4 * g4] * inv * bf_lo(gt[0]), O[dt][4 * g4 + 1] * inv * bf_hi(gt[0])),
                                                                       pk_bf16(O[dt][4 * g4 + 2] * inv * bf_lo(gt[1]), O[dt][4 * g4 + 3] * inv * bf_hi(gt[1]))}; }
    __syncthreads();
}

DI void reta_tile(const Params& p, int item, LAS uchar* lds) {
    const int tid = otid(), w = tid >> 6, lane = tid & 63, rl = lane & 31, h = lane >> 5;
    const bf16_t* P0 = (const bf16_t*)(p.ws + W_P0);
    const int c = item >> 3, hd = item & 7; const float lg = log1pf(-exp2f(-5.f - (float)hd));
    LAS uchar* Kl = lds; LAS uchar* Vl = lds + 40960;
#pragma unroll
    for (int i = 0; i < 4; ++i) { const int piece = tid + 512 * i, j = piece >> 4, c16 = piece & 15;
        const u32x4 raw = *(const u32x4*)(P0 + (size_t)(c * 128 + j) * LD0 + 1024 + hd * 128 + c16 * 8); const float dec = __expf(lg * (float)(127 - j));
        u32x4 o; for (int q = 0; q < 4; ++q) o[q] = pk_bf16(bf_lo(raw[q]) * dec, bf_hi(raw[q]) * dec);
        *(LAS u32x4*)(Kl + j * 320 + c16 * 16) = o; }
#pragma unroll
    for (int i = 0; i < 8; ++i) { const int piece = tid + 512 * i, j = piece >> 5, c16 = piece & 31;
        *(LAS u32x4*)(Vl + j * 576 + c16 * 16) = *(const u32x4*)(P0 + (size_t)(c * 128 + j) * LD0 + 2048 + hd * 256 + c16 * 8); }
    __syncthreads();
    f32x16 acc[4]; for (int dt = 0; dt < 4; ++dt) for (int i = 0; i < 16; ++i) acc[dt][i] = 0.f;
#pragma unroll
    for (int ks = 0; ks < 8; ++ks) { const bf16x8 a = tr_frag(Vl, 576, 16 * ks + 8 * h, 16 * ks + 8 * h + 4, 32 * w, lane);
#pragma unroll
        for (int dt = 0; dt < 4; ++dt) { const bf16x8 b = tr_frag(Kl, 320, 16 * ks + 8 * h, 16 * ks + 8 * h + 4, 32 * dt, lane); acc[dt] = MFMA32(a, b, acc[dt]); } }
    bf16_t* KVT = (bf16_t*)(p.ws + W_KVT) + (size_t)(c * 8 + hd) * 256 * 128;
#pragma unroll
    for (int dt = 0; dt < 4; ++dt)
#pragma unroll
        for (int i = 0; i < 16; ++i) KVT[(size_t)(32 * w + crow(i, h)) * 128 + 32 * dt + rl] = f2bf(acc[dt][i]);
    __syncthreads();
}

DI void retc_tile(const Params& p, int item, LAS uchar* lds) {
    const int tid = otid(), w = tid >> 6, lane = tid & 63, rl = lane & 31, h = lane >> 5;
    const bf16_t* P0 = (const bf16_t*)(p.ws + W_P0);
    const int c = item >> 3, hd = item & 7; const float lg = log1pf(-exp2f(-5.f - (float)hd));
    LAS uchar* Vl = lds; LAS float* red = (LAS float*)(lds + 73728);
#pragma unroll
    for (int i = 0; i < 8; ++i) { const int piece = tid + 512 * i, j = piece >> 5, c16 = piece & 31;
        *(LAS u32x4*)(Vl + j * 576 + c16 * 16) = *(const u32x4*)(P0 + (size_t)(c * 128 + j) * LD0 + 2048 + hd * 256 + c16 * 8); }
    __syncthreads();
    const int qg = w & 3, eh = w >> 2, qi = 32 * qg + rl; const size_t posq = (size_t)c * 128 + qi;
    bf16x8 qf[8];
#pragma unroll
    for (int ks = 0; ks < 8; ++ks) qf[ks] = *(const bf16x8*)(P0 + posq * LD0 + hd * 128 + 16 * ks + 8 * h);
    f32x16 acc[4]; for (int et = 0; et < 4; ++et) for (int i = 0; i < 16; ++i) acc[et][i] = 0.f;
    if (c > 0) {
        const bf16_t* ST = (const bf16_t*)(p.ws + W_STB) + (size_t)(c * 8 + hd) * 256 * 128;
#pragma unroll
        for (int ks = 0; ks < 8; ++ks)
#pragma unroll
            for (int et = 0; et < 4; ++et) { const bf16x8 a = *(const bf16x8*)(ST + (size_t)(128 * eh + 32 * et + rl) * 128 + 16 * ks + 8 * h); acc[et] = MFMA32(a, qf[ks], acc[et]); }
        const float qd = __expf(lg * (float)(qi + 1));
#pragma unroll
        for (int et = 0; et < 4; ++et) acc[et] *= qd;
    }
    bf16x8 kf[8], kfn[8];
    const bf16_t* KFR = (const bf16_t*)(p.ws + W_KFR) + ((size_t)hd * 256 + c * 4) * 4096;
    auto kptr = [&](int jc) { return KFR + (size_t)(jc < qg ? jc : qg) * 4096; };
    auto chunk = [&](const bf16x8 (&kk)[8], int jc) {
        f32x16 s; for (int i = 0; i < 16; ++i) s[i] = 0.f;
#pragma unroll
        for (int ks = 0; ks < 8; ++ks) s = MFMA32(kk[ks], qf[ks], s);
#pragma unroll
        for (int i = 0; i < 16; ++i) { const int diff = qi - (32 * jc + crow(i, h)); s[i] = diff >= 0 ? s[i] * __expf(lg * (float)diff) : 0.f; }
        const bf16x8 pf0 = pack8(s[0], s[1], s[2], s[3], s[4], s[5], s[6], s[7]), pf1 = pack8(s[8], s[9], s[10], s[11], s[12], s[13], s[14], s[15]);
#pragma unroll
        for (int et = 0; et < 4; ++et) {
            const bf16x8 a0 = tr_frag(Vl, 576, 32 * jc + 4 * h, 32 * jc + 8 + 4 * h, 128 * eh + 32 * et, lane); acc[et] = MFMA32(a0, pf0, acc[et]);
            const bf16x8 a1 = tr_frag(Vl, 576, 32 * jc + 16 + 4 * h, 32 * jc + 24 + 4 * h, 128 * eh + 32 * et, lane); acc[et] = MFMA32(a1, pf1, acc[et]);
        }
    };
    load_kfm(kf, kptr(0), lane);
    for (int jc = 0;;) {
        load_kfm(kfn, kptr(jc + 1), lane); __builtin_amdgcn_sched_barrier(0);
        chunk(kf, jc);
        if (++jc > qg) break;
        load_kfm(kf, kptr(jc + 1), lane); __builtin_amdgcn_sched_barrier(0);
        chunk(kfn, jc);
        if (++jc > qg) break;
    }
    float s1 = 0.f, s2 = 0.f;
#pragma unroll
    for (int et = 0; et < 4; ++et)
#pragma unroll
        for (int i = 0; i < 16; ++i) { const float v = acc[et][i]; s1 += v; s2 += v * v; }
    s1 += __shfl_xor(s1, 32); s2 += __shfl_xor(s2, 32);
    if (h == 0) { red[(w * 32 + rl) * 2] = s1; red[(w * 32 + rl) * 2 + 1] = s2; }
    __syncthreads();
    const float t1 = s1 + red[((w ^ 4) * 32 + rl) * 2], t2 = s2 + red[((w ^ 4) * 32 + rl) * 2 + 1];
    const float mu = t1 * (1.f / 256.f), var = t2 * (1.f / 256.f) - mu * mu, rstd = rsqrtf(fmaxf(var, 0.f) + 1e-6f);
    bf16_t* CAT0 = (bf16_t*)(p.ws + W_CAT0);
#pragma unroll
    for (int et = 0; et < 4; ++et)
#pragma unroll
        for (int g4 = 0; g4 < 4; ++g4) { const int e0 = 128 * eh + 32 * et + 8 * g4 + 4 * h;
            const f32x4 gn = *(const f32x4*)(p.ret_gn + hd * 256 + e0); const u32x2 gt = *(const u32x2*)(P0 + posq * LD0 + 4096 + hd * 256 + e0);
            const float y0 = (acc[et][4 * g4] - mu) * rstd * gn[0] * bf_lo(gt[0]), y1 = (acc[et][4 * g4 + 1] - mu) * rstd * gn[1] * bf_hi(gt[0]);
            const float y2 = (acc[et][4 * g4 + 2] - mu) * rstd * gn[2] * bf_lo(gt[1]), y3 = (acc[et][4 * g4 + 3] - mu) * rstd * gn[3] * bf_hi(gt[1]);
            *(u32x2*)(CAT0 + posq * LDC0 + hd * 256 + e0) = (u32x2){pk_bf16(y0, y1), pk_bf16(y2, y3)}; }
    __syncthreads();
}

DI void gate_tile(const Params& p, int item, LAS uchar* lds) {
    const int tid = otid(), w = tid >> 6, lane = tid & 63, rl = lane & 31, h = lane >> 5;
    const bf16_t* P1 = (const bf16_t*)(p.ws + W_P1); const float* lns = (const float*)(p.ws + W_LNS);
    const int c = item >> 3, gp = item & 7, ch0 = gp * 256;
    LAS uchar* Vl = lds;
#pragma unroll
    for (int i = 0; i < 8; ++i) { const int piece = tid + 512 * i, s = piece >> 5, c16 = piece & 31; const int pos = c * 128 + s;
        const u32x4 raw = *(const u32x4*)(P1 + (size_t)pos * LD1 + 2048 + ch0 + c16 * 8);
        const float mu = lns[2 * pos] * (1.f / 2048.f), var = lns[2 * pos + 1] * (1.f / 2048.f) - mu * mu, rstd = rsqrtf(fmaxf(var, 0.f) + 1e-6f);
        const f32x4 g0 = *(const f32x4*)(p.gmlp_ln + ch0 + c16 * 8), g1 = *(const f32x4*)(p.gmlp_ln + ch0 + c16 * 8 + 4);
        f32x4 a = {(bf_lo(raw[0]) - mu) * rstd * g0[0], (bf_hi(raw[0]) - mu) * rstd * g0[1], (bf_lo(raw[1]) - mu) * rstd * g0[2], (bf_hi(raw[1]) - mu) * rstd * g0[3]};
        f32x4 b = {(bf_lo(raw[2]) - mu) * rstd * g1[0], (bf_hi(raw[2]) - mu) * rstd * g1[1], (bf_lo(raw[3]) - mu) * rstd * g1[2], (bf_hi(raw[3]) - mu) * rstd * g1[3]};
        *(LAS u32x4*)(Vl + s * 576 + c16 * 16) = (u32x4){pk_bf16(a[0], a[1]), pk_bf16(a[2], a[3]), pk_bf16(b[0], b[1]), pk_bf16(b[2], b[3])};
        if (c == 63) { float* d = p.out + O_PGV + (size_t)s * 2048 + ch0 + c16 * 8; *(f32x4*)d = a; *(f32x4*)(d + 4) = b; } }
    __syncthreads();
    const int g = 2 * gp + (w >> 2), tq = w & 3;
    const bf16_t* WC = (const bf16_t*)(p.ws + W_WC) + (size_t)g * 128 * 128;
    f32x16 acc[4]; for (int n = 0; n < 4; ++n) for (int i = 0; i < 16; ++i) acc[n][i] = 0.f;
    for (int ks = 0; ks < 2 * tq + 2; ++ks) {
        const bf16x8 a = *(const bf16x8*)(WC + (size_t)(32 * tq + rl) * 128 + 16 * ks + 8 * h);
#pragma unroll
        for (int n = 0; n < 4; ++n) { const bf16x8 b = tr_frag(Vl, 576, 16 * ks + 8 * h, 16 * ks + 8 * h + 4, 128 * (w >> 2) + 32 * n, lane); acc[n] = MFMA32(a, b, acc[n]); }
    }
    bf16_t* CAT1 = (bf16_t*)(p.ws + W_CAT1);
    __syncthreads();
#pragma unroll
    for (int n = 0; n < 4; ++n)
#pragma unroll
        for (int i = 0; i < 16; ++i) { const int t = 32 * tq + crow(i, h);
            *(LAS bf16_t*)(Vl + t * 528 + (128 * (w >> 2) + 32 * n + rl) * 2) = f2bf(acc[n][i] + p.b_spatial[g * 128 + t]); }
    __syncthreads();
#pragma unroll
    for (int i = 0; i < 8; ++i) { const int piece = tid + 512 * i, t = piece >> 5, c16 = piece & 31; const size_t pos = (size_t)c * 128 + t;
        const u32x4 mx = *(LAS const u32x4*)(Vl + t * 528 + c16 * 16);
        const u32x4 uu = *(const u32x4*)(P1 + pos * LD1 + ch0 + c16 * 8), zz = *(const u32x4*)(P1 + pos * LD1 + 4096 + ch0 + c16 * 8); u32x4 r;
#pragma unroll
        for (int q = 0; q < 4; ++q) r[q] = pk_bf16(bf_lo(uu[q]) * bf_lo(mx[q]) * bf_lo(zz[q]), bf_hi(uu[q]) * bf_hi(mx[q]) * bf_hi(zz[q]));
        *(u32x4*)(CAT1 + pos * LDC1 + ch0 + c16 * 8) = r; }
    __syncthreads();
}

template <int HS>
DI void mini_gemm(const bf16_t* A, const bf16_t* Wt, float*  , bf16_t* O, LAS uchar* lds) {
    const int tid = otid(), w = tid >> 6, lane = tid & 63, rl = lane & 31, h = lane >> 5;
    constexpr int K = HS * 2 * 16 * 8;
    LAS float* red = (LAS float*)lds;
    for (int tile = blockIdx.x; tile < 256; tile += gridDim.x) {
        const int mt = tile & 3, nt = tile >> 2, k0 = w * (K >> 3);
        f32x16 acc; for (int i = 0; i < 16; ++i) acc[i] = 0.f;
        const bf16_t* ap = A + (size_t)(32 * mt + rl) * K + k0 + 8 * h; const bf16_t* bp = Wt + (size_t)(32 * nt + rl) * K + k0 + 8 * h;
#pragma unroll
        for (int half = 0; half < 2; ++half) {
            bf16x8 a[HS], b[HS];
#pragma unroll
            for (int q = 0; q < HS; ++q) { a[q] = *(const bf16x8*)(ap + 16 * (half * HS + q)); b[q] = *(const bf16x8*)(bp + 16 * (half * HS + q)); }
#pragma unroll
            for (int q = 0; q < HS; ++q) acc = MFMA32(a[q], b[q], acc);
        }
#pragma unroll
        for (int i = 0; i < 16; ++i) red[w * 1024 + i * 64 + lane] = acc[i];
        __syncthreads();
#pragma unroll
        for (int q = 0; q < 2; ++q) { const int idx = tid + 512 * q, i = idx >> 6, ln = idx & 63; float sum = 0.f;
#pragma unroll
            for (int ww = 0; ww < 8; ++ww) sum += red[ww * 1024 + idx];
            O[(size_t)(32 * mt + crow(i, ln >> 5)) * 2048 + 32 * nt + (ln & 31)] = f2bf(sum); }
        __syncthreads();
    }
}

template <class KF, class VF>
DI void wave_attn(LAS const float* q, int j0, int j1, KF krow, VF vrow, int lane, float& m, float& l, float (&a)[8]) {
    const int kg = lane >> 4, ds = lane & 15;
    const f32x4 q0 = *(LAS const f32x4*)(q + ds * 8), q1 = *(LAS const f32x4*)(q + ds * 8 + 4);
    for (int jb = j0; jb < j1; jb += 64) {
        float part[16];
#pragma unroll
        for (int i = 0; i < 16; ++i) { int j = jb + kg * 16 + i; j = j < j1 ? j : j1 - 1; const float* kp = krow(j) + ds * 8;
            const f32x4 k0 = *(const f32x4*)kp, k1 = *(const f32x4*)(kp + 4);
            part[i] = k0[0] * q0[0] + k0[1] * q0[1] + k0[2] * q0[2] + k0[3] * q0[3] + k1[0] * q1[0] + k1[1] * q1[1] + k1[2] * q1[2] + k1[3] * q1[3]; }
        float v8[8], v4[4], v2[2], s;
        { const bool hi = (ds & 8) != 0;
#pragma unroll
            for (int t = 0; t < 8; ++t) { const float send = hi ? part[t] : part[t + 8], keep = hi ? part[t + 8] : part[t]; v8[t] = keep + __shfl_xor(send, 8); } }
        { const bool hi = (ds & 4) != 0;
#pragma unroll
            for (int t = 0; t < 4; ++t) { const float send = hi ? v8[t] : v8[t + 4], keep = hi ? v8[t + 4] : v8[t]; v4[t] = keep + __shfl_xor(send, 4); } }
        { const bool hi = (ds & 2) != 0;
#pragma unroll
            for (int t = 0; t < 2; ++t) { const float send = hi ? v4[t] : v4[t + 2], keep = hi ? v4[t + 2] : v4[t]; v2[t] = keep + __shfl_xor(send, 2); } }
        { const bool hi = (ds & 1) != 0; const float send = hi ? v2[0] : v2[1], keep = hi ? v2[1] : v2[0]; s = keep + __shfl_xor(send, 1); }
        const bool valid = (jb + lane) < j1; s = valid ? s : -1e30f;
        const float mx = wave_max(s), mn = fmaxf(m, mx), alpha = __expf(m - mn); m = mn;
        const float pv = valid ? __expf(s - mn) : 0.f; l = l * alpha + wave_sum(pv);
#pragma unroll
        for (int t = 0; t < 8; ++t) a[t] *= alpha;
#pragma unroll
        for (int i = 0; i < 16; ++i) { int j = jb + kg * 16 + i; j = j < j1 ? j : j1 - 1; const float pj = __shfl(pv, kg * 16 + i); const float* vp = vrow(j) + ds * 8;
            const f32x4 x0 = *(const f32x4*)vp, x1 = *(const f32x4*)(vp + 4);
            a[0] += pj * x0[0]; a[1] += pj * x0[1]; a[2] += pj * x0[2]; a[3] += pj * x0[3]; a[4] += pj * x1[0]; a[5] += pj * x1[1]; a[6] += pj * x1[2]; a[7] += pj * x1[3]; }
    }
#pragma unroll
    for (int t = 0; t < 8; ++t) { a[t] += __shfl_xor(a[t], 16); a[t] += __shfl_xor(a[t], 32); }
}

DI void attn_merge_store(LAS float* mg, int t, int part, int lane, float m, float l, const float (&a)[8], const bf16_t* gate, bf16_t* dst) {
    if (part == 1 && lane < 16) { LAS float* o = mg + (t * 16 + lane) * 12; o[0] = m; o[1] = l;
#pragma unroll
        for (int q = 0; q < 8; ++q) o[2 + q] = a[q]; }
    __syncthreads();
    if (part == 0 && lane < 16) { LAS const float* o = mg + (t * 16 + lane) * 12; const float M = fmaxf(m, o[0]), w1 = __expf(m - M), w2 = __expf(o[0] - M);
        const float den = 1.f / (w1 * l + w2 * o[1]); const u32x4 gt = *(const u32x4*)(gate + 8 * lane); u32x4 r;
#pragma unroll
        for (int q = 0; q < 4; ++q) r[q] = pk_bf16((w1 * a[2 * q] + w2 * o[2 + 2 * q]) * den * bf_lo(gt[q]), (w1 * a[2 * q + 1] + w2 * o[3 + 2 * q]) * den * bf_hi(gt[q]));
        *(u32x4*)(dst + 8 * lane) = r; }
    __syncthreads();
}

DI void sdil_item(const Params& p, int item, LAS uchar* lds) {
    const int tid = otid(), w = tid >> 6, lane = tid & 63;
    const bf16_t* P0 = (const bf16_t*)(p.ws + W_P0);
    const int b = item >> 3, hd = item & 7, t = w & 3, part = w >> 2; const size_t R = TP + b * 4 + t;
    LAS float* q = (LAS float*)(lds + w * 512); LAS float* mg = (LAS float*)(lds + 4096);
    for (int dd = lane; dd < 128; dd += 64) { const int pp = dd < 32 ? 2 * (dd & 15) + (dd >> 4) : dd; q[dd] = bf2f(P0[R * LD0 + 6144 + hd * 128 + pp]); }
    __syncthreads();
    const float* newk = p.out + O_SSWAK; const float* newv = p.out + O_SSWAV;
    auto idxf = [&](int jm) { const int br = jm >> 7, j = (jm & 127) + 1; return 2048 + t - (j << (2 * br)); };
    auto krow = [&](int jm) { const int idx = idxf(jm); return idx >= 2048 ? newk + ((size_t)(b * 4 + idx - 2048) * 8 + hd) * 128 : p.cache_k + ((size_t)(b * 2048 + idx) * 8 + hd) * 128; };
    auto vrow = [&](int jm) { const int idx = idxf(jm); return idx >= 2048 ? newv + ((size_t)(b * 4 + idx - 2048) * 8 + hd) * 128 : p.cache_v + ((size_t)(b * 2048 + idx) * 8 + hd) * 128; };
    float m = -1e30f, l = 0.f, a[8] = {0.f, 0.f, 0.f, 0.f, 0.f, 0.f, 0.f, 0.f};
    const int ds = lane & 15;
    const float* ks = newk + ((size_t)(b * 4 + t) * 8 + hd) * 128 + ds * 8; const float* vs = newv + ((size_t)(b * 4 + t) * 8 + hd) * 128 + ds * 8;
    wave_attn(q, part * 192, part * 192 + 192, krow, vrow, lane, m, l, a);
    if (part == 0) {
        const f32x4 ks0 = *(const f32x4*)ks, ks1 = *(const f32x4*)(ks + 4), vs0 = *(const f32x4*)vs, vs1 = *(const f32x4*)(vs + 4);
        const f32x4 q0 = *(LAS const f32x4*)(q + ds * 8), q1 = *(LAS const f32x4*)(q + ds * 8 + 4);
        float sd = ks0[0] * q0[0] + ks0[1] * q0[1] + ks0[2] * q0[2] + ks0[3] * q0[3] + ks1[0] * q1[0] + ks1[1] * q1[1] + ks1[2] * q1[2] + ks1[3] * q1[3];
        sd += __shfl_xor(sd, 1); sd += __shfl_xor(sd, 2); sd += __shfl_xor(sd, 4); sd += __shfl_xor(sd, 8);
        const float mn = fmaxf(m, sd), al = __expf(m - mn), pw = 3.f * __expf(sd - mn); m = mn; l = l * al + pw;
        a[0] = a[0] * al + pw * vs0[0]; a[1] = a[1] * al + pw * vs0[1]; a[2] = a[2] * al + pw * vs0[2]; a[3] = a[3] * al + pw * vs0[3];
        a[4] = a[4] * al + pw * vs1[0]; a[5] = a[5] * al + pw * vs1[1]; a[6] = a[6] * al + pw * vs1[2]; a[7] = a[7] * al + pw * vs1[3];
    }
    attn_merge_store(mg, t, part, lane, m, l, a, P0 + R * LD0 + 9216 + hd * 128, (bf16_t*)(p.ws + W_CAT0) + R * LDC0 + 2048 + hd * 128);
}

DI void smem_item(const Params& p, int item, int layer, LAS uchar* lds) {
    const int tid = otid(), w = tid >> 6, lane = tid & 63;
    const bf16_t* PX = (const bf16_t*)(p.ws + (layer ? W_P1 : W_P0)); const int ld = layer ? LD1 : LD0, qcol = layer ? 6144 : 10240, gcol = layer ? 6656 : 10752;
    bf16_t* CAT = (bf16_t*)(p.ws + (layer ? W_CAT1 : W_CAT0)); const int ldc = layer ? LDC1 : LDC0, ccol = layer ? 2048 : 3072;
    const int b = item >> 2, hd = item & 3, t = w & 3, part = w >> 2; const size_t R = TP + b * 4 + t;
    LAS float* q = (LAS float*)(lds + w * 512); LAS float* mg = (LAS float*)(lds + 4096);
    for (int dd = lane; dd < 128; dd += 64) q[dd] = bf2f(PX[R * ld + qcol + hd * 128 + dd]);
    __syncthreads();
    const float* kb = p.cmem_k + ((size_t)(layer * 32 + b) * 256 * 4 + hd) * 128; const float* vb = p.cmem_v + ((size_t)(layer * 32 + b) * 256 * 4 + hd) * 128;
    auto krow = [&](int j) { return kb + (size_t)j * 512; };
    auto vrow = [&](int j) { return vb + (size_t)j * 512; };
    float m = -1e30f, l = 0.f, a[8] = {0.f, 0.f, 0.f, 0.f, 0.f, 0.f, 0.f, 0.f};
    wave_attn(q, part * 128, part * 128 + 128, krow, vrow, lane, m, l, a);
    attn_merge_store(mg, t, part, lane, m, l, a, PX + R * ld + gcol + hd * 128, CAT + R * ldc + ccol + hd * 128);
}

DI void sret_item(const Params& p, int item, LAS uchar* lds) {
    const int tid = otid(), w = tid >> 6, lane = tid & 63;
    const bf16_t* P0 = (const bf16_t*)(p.ws + W_P0);
    const int b = item >> 3, hd = item & 7; const float lg = log1pf(-exp2f(-5.f - (float)hd));
    LAS float* qn = (LAS float*)lds; LAS float* kn = qn + 512; LAS float* sc = kn + 512; LAS float* gr = sc + 16; LAS float* red = gr + 48;
    const size_t R0 = TP + b * 4;
    { const int t = tid >> 7, d = tid & 127, pp = 2 * (d & 63) + (d >> 6);
        qn[t * 128 + d] = bf2f(P0[(R0 + t) * LD0 + hd * 128 + pp]); kn[t * 128 + d] = bf2f(P0[(R0 + t) * LD0 + 1024 + hd * 128 + pp]); }
    f32x4 v[4];
#pragma unroll
    for (int t = 0; t < 4; ++t) { const u32x2 r = *(const u32x2*)(P0 + (R0 + t) * LD0 + 2048 + hd * 256 + 4 * lane); v[t] = (f32x4){bf_lo(r[0]), bf_hi(r[0]), bf_lo(r[1]), bf_hi(r[1])}; }
    __syncthreads();
    if (tid < 16) { const int i = tid >> 2, j = tid & 3; float s = 0.f; for (int d = 0; d < 128; ++d) s += qn[i * 128 + d] * kn[j * 128 + d]; sc[tid] = j <= i ? s * __expf(lg * (float)(i - j)) : 0.f; }
    const float g1 = __expf(lg), g2 = g1 * g1, g3 = g2 * g1, g4 = g2 * g2;
    const float* sin_ = p.state_ret + ((size_t)(b * 8 + hd) * 128) * 256 + 4 * lane; float* sout = p.out + O_SSTATE + ((size_t)(b * 8 + hd) * 128) * 256 + 4 * lane;
    f32x4 cr[4]; for (int i = 0; i < 4; ++i) cr[i] = (f32x4){0.f, 0.f, 0.f, 0.f};
    const f32x4 kv0 = g3 * v[0], kv1 = g2 * v[1], kv2 = g1 * v[2], kv3 = v[3];
    f32x4 st[16];
#pragma unroll
    for (int dd = 0; dd < 16; ++dd) st[dd] = *(const f32x4*)(sin_ + (size_t)(16 * w + dd) * 256);
#pragma unroll
    for (int dd = 0; dd < 16; ++dd) { const int d = 16 * w + dd;
        cr[0] += qn[d] * st[dd]; cr[1] += qn[128 + d] * st[dd]; cr[2] += qn[256 + d] * st[dd]; cr[3] += qn[384 + d] * st[dd];
        *(f32x4*)(sout + (size_t)d * 256) = g4 * st[dd] + kn[d] * kv0 + kn[128 + d] * kv1 + kn[256 + d] * kv2 + kn[384 + d] * kv3; }
#pragma unroll
    for (int i = 0; i < 4; ++i) *(LAS f32x4*)(red + (w * 4 + i) * 256 + 4 * lane) = cr[i];
    __syncthreads();
    const int e = tid & 255; float o[4] = {0.f, 0.f, 0.f, 0.f};
    if (tid < 256) {
        float ve[4];
#pragma unroll
        for (int t = 0; t < 4; ++t) ve[t] = bf2f(P0[(R0 + t) * LD0 + 2048 + hd * 256 + e]);
        const float gp[4] = {g1, g2, g3, g4};
#pragma unroll
        for (int i = 0; i < 4; ++i) { float x = 0.f;
#pragma unroll
            for (int ww = 0; ww < 8; ++ww) x += red[(ww * 4 + i) * 256 + e];
            x *= gp[i];
#pragma unroll
            for (int j = 0; j < 4; ++j) if (j <= i) x += sc[i * 4 + j] * ve[j];
            o[i] = x; }
#pragma unroll
        for (int i = 0; i < 4; ++i) { const float aa = wave_sum(o[i]), bq = wave_sum(o[i] * o[i]); if (lane == 0) { gr[(w * 4 + i) * 2] = aa; gr[(w * 4 + i) * 2 + 1] = bq; } }
    }
    __syncthreads();
    if (tid < 256) {
        bf16_t* CAT0 = (bf16_t*)(p.ws + W_CAT0); const float gn = p.ret_gn[hd * 256 + e];
#pragma unroll
        for (int i = 0; i < 4; ++i) { float t1 = 0.f, t2 = 0.f; for (int ww = 0; ww < 4; ++ww) { t1 += gr[(ww * 4 + i) * 2]; t2 += gr[(ww * 4 + i) * 2 + 1]; }
            const float mu = t1 * (1.f / 256.f), var = t2 * (1.f / 256.f) - mu * mu, rstd = rsqrtf(fmaxf(var, 0.f) + 1e-6f);
            CAT0[(R0 + i) * LDC0 + hd * 256 + e] = f2bf((o[i] - mu) * rstd * gn * bf2f(P0[(R0 + i) * LD0 + 4096 + hd * 256 + e])); }
    }
    __syncthreads();
}

DI void sgate_item(const Params& p, int b) {
    const int tid = otid(); const int ch = tid * 4, g = ch >> 7;
    const bf16_t* P1 = (const bf16_t*)(p.ws + W_P1); const float* lns = (const float*)(p.ws + W_LNS); bf16_t* CAT1 = (bf16_t*)(p.ws + W_CAT1);
    const size_t R0 = TP + b * 4;
    const f32x4 gl = *(const f32x4*)(p.gmlp_ln + ch);
    f32x4 vn[4];
#pragma unroll
    for (int t = 0; t < 4; ++t) { const size_t R = R0 + t; const u32x2 raw = *(const u32x2*)(P1 + R * LD1 + 2048 + ch);
        const float mu = lns[2 * R] * (1.f / 2048.f), var = lns[2 * R + 1] * (1.f / 2048.f) - mu * mu, rstd = rsqrtf(fmaxf(var, 0.f) + 1e-6f);
        vn[t] = (f32x4){(bf_lo(raw[0]) - mu) * rstd * gl[0], (bf_hi(raw[0]) - mu) * rstd * gl[1], (bf_lo(raw[1]) - mu) * rstd * gl[2], (bf_hi(raw[1]) - mu) * rstd * gl[3]};
        *(f32x4*)(p.out + O_SGV + (size_t)(b * 4 + t) * 2048 + ch) = vn[t]; }
#pragma unroll
    for (int t = 0; t < 4; ++t) { const size_t R = R0 + t; const float bias = p.b_spatial[g * 128 + t]; f32x4 mixed = {bias, bias, bias, bias};
#pragma unroll
        for (int s = 0; s < 4; ++s) if (s <= t) mixed += p.w_spatial[(size_t)g * 16384 + t * 128 + s] * vn[s];
        const u32x2 ur = *(const u32x2*)(P1 + R * LD1 + ch), zr = *(const u32x2*)(P1 + R * LD1 + 4096 + ch);
        *(u32x2*)(CAT1 + R * LDC1 + ch) = (u32x2){pk_bf16(bf_lo(ur[0]) * mixed[0] * bf_lo(zr[0]), bf_hi(ur[0]) * mixed[1] * bf_hi(zr[0])),
                                                  pk_bf16(bf_lo(ur[1]) * mixed[2] * bf_lo(zr[1]), bf_hi(ur[1]) * mixed[3] * bf_hi(zr[1]))}; }
}

DI void phase3(const Params& p) {
    int G = gridDim.x; asm volatile("" : "+s"(G));
    const int tid = otid(), B = blockIdx.x;
    const bf16_t* KVT = (const bf16_t*)(p.ws + W_KVT); bf16_t* STB = (bf16_t*)(p.ws + W_STB);
    for (int idx = B * 512 + tid; idx < 131072; idx += G * 512) {
        const int d2 = idx & 63, e = (idx >> 6) & 255, hd = idx >> 14;
        const float gd = __expf(128.f * log1pf(-exp2f(-5.f - (float)hd)));
        const size_t off = ((size_t)hd * 256 + e) * 128 + 2 * d2;
        float s0 = 0.f, s1 = 0.f;
#pragma unroll 16
        for (int c = 0; c < 64; ++c) { const unsigned kr = *(const unsigned*)(KVT + (size_t)c * 262144 + off); const f32x2 kv = {bf_lo(kr), bf_hi(kr)};
            *(unsigned*)(STB + (size_t)c * 262144 + off) = pk_bf16(s0, s1);
            s0 = gd * s0 + kv[0]; s1 = gd * s1 + kv[1]; }
        p.out[O_PSTATE + ((size_t)hd * 128 + d2) * 256 + e] = s0; p.out[O_PSTATE + ((size_t)hd * 128 + d2 + 64) * 256 + e] = s1;
    }
    const bf16_t* DO = (const bf16_t*)(p.ws + W_DILO); const float* DM = (const float*)(p.ws + W_DILM); const float* DL = (const float*)(p.ws + W_DILL);
    const bf16_t* P0 = (const bf16_t*)(p.ws + W_P0); bf16_t* CAT0 = (bf16_t*)(p.ws + W_CAT0);
#pragma unroll 2
    for (int idx = B * 512 + tid; idx < 8192 * 8 * 16; idx += G * 512) {
        const int c16 = idx & 15, hd = (idx >> 4) & 7; const size_t pos = idx >> 7;
        float mm[3], ll[3]; for (int b = 0; b < 3; ++b) { mm[b] = DM[((size_t)b * 8192 + pos) * 8 + hd]; ll[b] = DL[((size_t)b * 8192 + pos) * 8 + hd]; }
        const float M = fmaxf(mm[0], fmaxf(mm[1], mm[2])); float wt[3], den = 0.f; for (int b = 0; b < 3; ++b) { wt[b] = __expf(mm[b] - M) * ll[b]; den += wt[b]; }
        const float inv = 1.f / den; float acc[8] = {0.f, 0.f, 0.f, 0.f, 0.f, 0.f, 0.f, 0.f};
#pragma unroll
        for (int b = 0; b < 3; ++b) { const u32x4 o = *(const u32x4*)(DO + ((size_t)b * 8192 + pos) * 1024 + hd * 128 + c16 * 8); const float ww = wt[b] * inv;
#pragma unroll
            for (int q = 0; q < 4; ++q) { acc[2 * q] += ww * bf_lo(o[q]); acc[2 * q + 1] += ww * bf_hi(o[q]); } }
        const u32x4 gt = *(const u32x4*)(P0 + pos * LD0 + 9216 + hd * 128 + c16 * 8); u32x4 r;
#pragma unroll
        for (int q = 0; q < 4; ++q) r[q] = pk_bf16(acc[2 * q] * bf_lo(gt[q]), acc[2 * q + 1] * bf_hi(gt[q]));
        *(u32x4*)(CAT0 + pos * LDC0 + 2048 + hd * 128 + c16 * 8) = r;
    }
}

DI void load_o8(const bf16_t* os, int lane, f32x4 (&v)[8]) {
#pragma unroll
    for (int i = 0; i < 4; ++i) { const u32x4 r = *(const u32x4*)(os + (i * 64 + lane) * 8);
        v[2 * i] = (f32x4){bf_lo(r[0]), bf_hi(r[0]), bf_lo(r[1]), bf_hi(r[1])}; v[2 * i + 1] = (f32x4){bf_lo(r[2]), bf_hi(r[2]), bf_lo(r[3]), bf_hi(r[3])}; }
}
DI int o8_off(int i, int lane) { return ((i >> 1) * 64 + lane) * 8 + (i & 1) * 4; }
DI void phase6(const Params& p) {
    const int tid = otid(), wid = tid >> 6, lane = tid & 63, G = gridDim.x, B = blockIdx.x;
    const bf16_t* O = (const bf16_t*)(p.ws + W_O); bf16_t* XN1 = (bf16_t*)(p.ws + W_XN1);
    for (int row = B * 8 + wid; row < MPAD; row += G * 8) {
        bf16_t* dst = XN1 + (size_t)row * 2048;
        if (row >= NROW) { for (int i = 0; i < 8; ++i) *(u32x2*)(dst + (i * 64 + lane) * 4) = (u32x2){0u, 0u}; continue; }
        const float* xs = row < TP ? p.x_prompt + (size_t)row * 2048 : p.x_sample + (size_t)(row - TP) * 2048;
        float* hd = p.out + O_Y + (size_t)row * 2048;
        f32x4 v[8], x[8]; float ss = 0.f;
        load_o8(O + (size_t)row * 2048, lane, v);
#pragma unroll
        for (int i = 0; i < 8; ++i) x[i] = *(const f32x4*)(xs + o8_off(i, lane));
#pragma unroll
        for (int i = 0; i < 8; ++i) ss += v[i][0] * v[i][0] + v[i][1] * v[i][1] + v[i][2] * v[i][2] + v[i][3] * v[i][3];
        ss = wave_sum(ss); const float rs = rsqrtf(ss * (1.f / 2048.f) + 1e-6f); float s2 = 0.f;
#pragma unroll
        for (int i = 0; i < 8; ++i) { const f32x4 g = *(const f32x4*)(p.post_norm + o8_off(i, lane));
            v[i] = x[i] + v[i] * rs * g; *(f32x4*)(hd + o8_off(i, lane)) = v[i]; s2 += v[i][0] * v[i][0] + v[i][1] * v[i][1] + v[i][2] * v[i][2] + v[i][3] * v[i][3]; }
        s2 = wave_sum(s2); const float r2 = rsqrtf(s2 * (1.f / 2048.f) + 1e-6f);
#pragma unroll
        for (int i = 0; i < 4; ++i) { const f32x4 g0 = *(const f32x4*)(p.pre_norm + 2048 + o8_off(2 * i, lane)), g1 = *(const f32x4*)(p.pre_norm + 2048 + o8_off(2 * i + 1, lane));
            const f32x4 a = v[2 * i] * r2 * g0, b = v[2 * i + 1] * r2 * g1;
            *(u32x4*)(dst + (i * 64 + lane) * 8) = (u32x4){pk_bf16(a[0], a[1]), pk_bf16(a[2], a[3]), pk_bf16(b[0], b[1]), pk_bf16(b[2], b[3])}; }
    }
}

DI void phase10(const Params& p) {
    const int tid = otid(), wid = tid >> 6, lane = tid & 63, G = gridDim.x, B = blockIdx.x;
    const bf16_t* O = (const bf16_t*)(p.ws + W_O);
    for (int row = B * 8 + wid; row < NROW; row += G * 8) {
        float* hd = p.out + O_Y + (size_t)row * 2048;
        f32x4 v[8], x[8]; float ss = 0.f;
        load_o8(O + (size_t)row * 2048, lane, v);
#pragma unroll
        for (int i = 0; i < 8; ++i) x[i] = *(const f32x4*)(hd + o8_off(i, lane));
#pragma unroll
        for (int i = 0; i < 8; ++i) ss += v[i][0] * v[i][0] + v[i][1] * v[i][1] + v[i][2] * v[i][2] + v[i][3] * v[i][3];
        ss = wave_sum(ss); const float rs = rsqrtf(ss * (1.f / 2048.f) + 1e-6f);
#pragma unroll
        for (int i = 0; i < 8; ++i) { const f32x4 g = *(const f32x4*)(p.post_norm + 2048 + o8_off(i, lane));
            *(f32x4*)(hd + o8_off(i, lane)) = x[i] + v[i] * rs * g; }
    }
}

#ifndef REP_DIL
#define REP_DIL 1
#endif
#ifndef REP_RETA
#define REP_RETA 1
#endif
#ifndef REP_MEM
#define REP_MEM 1
#endif
#ifndef REP_SRET
#define REP_SRET 1
#endif
#ifndef REP_SDIL
#define REP_SDIL 1
#endif
#ifndef REP_P3
#define REP_P3 1
#endif
#ifndef REP_P4
#define REP_P4 1
#endif
#ifndef REP_P8
#define REP_P8 1
#endif
#ifndef REP_P0
#define REP_P0 1
#endif
#ifndef REP_G1
#define REP_G1 1
#endif
#ifndef REP_P2
#define REP_P2 1
#endif
__global__ void __launch_bounds__(512) mega_fwd(Params p) {
    extern __shared__ __attribute__((aligned(16))) uchar smem[];
    LAS uchar* lds = (LAS uchar*)smem;
    cg::grid_group grid = cg::this_grid();
    const int G = gridDim.x, B = blockIdx.x;
    uchar* ws = p.ws;
    if (otid() < 4) ((LAS unsigned*)(lds + LDS_BAR_OFF))[otid()] = 0u;
    __syncthreads();
    XcdBarrier xb = xcd_barrier_post((unsigned*)(ws + W_BAR), (volatile LAS unsigned*)(lds + LDS_BAR_OFF));
    if (p.out == nullptr) grid.sync();

    for (int rep = 0; rep < REP_P0; ++rep) phase0(p, lds);
    xcd_barrier(xb);
    {
        pg8::Gemm g{(const bf16_t*)(ws + W_A0), (const bf16_t*)(ws + W_WT1), MPAD, LD0, 2048};
        pg8::StaticOrder S; S.init(MPAD, LD0, G, B, 8);
        Epi1 E{(bf16_t*)(ws + W_P0), (bf16_t*)(ws + W_MEMKV), p.out, (const float*)(ws + W_TAC), (const float*)(ws + W_TAS), (const float*)(ws + W_TBC), (const float*)(ws + W_TBS), (bf16_t*)(ws + W_KFD), (bf16_t*)(ws + W_KFR), (bf16_t*)(ws + W_KFM)};
        { const int rem = 1460 % G;
          if (rem > 0) { if (B >= rem) wconv(p, lds, 2816, 5504, B - rem, G - rem); } else wconv(p, lds, 2816, 5504, B, G); }
        for (int rep = 0; rep < REP_G1; ++rep) pg8::gemm_phase(lds, g, S, E);
    }
    xcd_barrier(xb);
    for (int rep = 0; rep < REP_P2; ++rep)
    for (int it = B; it < 2048; it += G) {
        const int item = ((B & 1) && G == 256) ? ((it + 1280) & 2047) : it;
        if (item < 768) { for (int q = 0; q < REP_DIL; ++q) dil_tile(p, item, lds); }
        else if (item < 1280) { for (int q = 0; q < REP_RETA; ++q) reta_tile(p, item - 768, lds); }
        else if (item < 1408) { for (int q = 0; q < REP_MEM; ++q) memp_tile(p, item - 1280, 0, lds); }
        else if (item < 1664) { for (int q = 0; q < REP_SRET; ++q) sret_item(p, item - 1408, lds); }
        else if (item < 1920) { for (int q = 0; q < REP_SDIL; ++q) sdil_item(p, item - 1664, lds); }
        else { for (int q = 0; q < REP_MEM; ++q) smem_item(p, item - 1920, 0, lds); }
    }
    xcd_barrier(xb);
    for (int rep = 0; rep < REP_P3; ++rep) phase3(p);
    xcd_barrier(xb);
    for (int rep = 0; rep < REP_P4; ++rep)
    for (int item = B; item < 512; item += G) retc_tile(p, item, lds);
    xcd_barrier(xb);
    {
        pg8::Gemm g{(const bf16_t*)(ws + W_CAT0), (const bf16_t*)(ws + W_WT2), TP, 2048, LDC0};
        pg8::StaticOrder S; S.init(TP, 2048, G, B, 0);
        EpiO E{(bf16_t*)(ws + W_O)};
        pg8::gemm_phase(lds, g, S, E);
        mini_gemm<14>((const bf16_t*)(ws + W_CAT0) + (size_t)TP * LDC0, (const bf16_t*)(ws + W_WT2), nullptr, (bf16_t*)(ws + W_O) + (size_t)TP * 2048, lds);
    }
    xcd_barrier(xb);
    phase6(p);
    xcd_barrier(xb);
    {
        pg8::Gemm g{(const bf16_t*)(ws + W_XN1), (const bf16_t*)(ws + W_WT3), MPAD, LD1, 2048};
        pg8::StaticOrder S; S.init(MPAD, LD1, G, B, 0);
        Epi3 E{(bf16_t*)(ws + W_P1), (float*)(ws + W_LNS)};
        { const int rem = 924 % G;
          if (rem > 0) { if (B >= rem) wconv(p, lds, 5504, 6144, B - rem, G - rem); } else wconv(p, lds, 5504, 6144, B, G); }
        pg8::gemm_phase(lds, g, S, E);
    }
    xcd_barrier(xb);
    for (int rep = 0; rep < REP_P8; ++rep)
    for (int item = B; item < 800; item += G) {
        if (item < 512) gate_tile(p, item, lds);
        else if (item < 640) memp_tile(p, item - 512, 1, lds);
        else if (item < 768) smem_item(p, item - 640, 1, lds);
        else sgate_item(p, item - 768);
    }
    xcd_barrier(xb);
    {
        pg8::Gemm g{(const bf16_t*)(ws + W_CAT1), (const bf16_t*)(ws + W_WT4), TP, 2048, LDC1};
        pg8::StaticOrder S; S.init(TP, 2048, G, B, 0);
        EpiO E{(bf16_t*)(ws + W_O)};
        pg8::gemm_phase(lds, g, S, E);
        mini_gemm<10>((const bf16_t*)(ws + W_CAT1) + (size_t)TP * LDC1, (const bf16_t*)(ws + W_WT4), nullptr, (bf16_t*)(ws + W_O) + (size_t)TP * 2048, lds);
    }
    xcd_barrier(xb);
    phase10(p);
}

extern "C" void kernel_launch(void* const* d_in, const int* in_sizes, int n_in, void* d_out, int out_size, void* d_ws, size_t ws_size, hipStream_t stream) {
    static int grid_blocks = 0;
    if (!grid_blocks) {
        int dev = 0, cus = 0, per_cu = 0;
        hipGetDevice(&dev);
        hipDeviceGetAttribute(&cus, hipDeviceAttributeMultiprocessorCount, dev);
        hipFuncSetAttribute((const void*)mega_fwd, hipFuncAttributeMaxDynamicSharedMemorySize, LDS_BYTES);
        hipOccupancyMaxActiveBlocksPerMultiprocessor(&per_cu, (const void*)mega_fwd, 512, LDS_BYTES);
        if (per_cu < 1) { fprintf(stderr, "occupancy query returned %d\n", per_cu); per_cu = 1; }
        grid_blocks = cus;
        if (ws_size < W_END) fprintf(stderr, "workspace too small: %zu < %zu\n", ws_size, (size_t)W_END);
    }
    Params p{};
    const float** pp = (const float**)&p;
    for (int i = 0; i < 21; ++i) pp[i] = (const float*)d_in[i];
    p.out = (float*)d_out; p.ws = (uchar*)d_ws;
    (void)hipMemsetAsync((uchar*)d_ws + W_BAR, 0, (size_t)XCD_BAR_WORDS_C * 4, stream);
    void* args[] = {&p};
    hipError_t e = hipLaunchCooperativeKernel((const void*)mega_fwd, dim3(grid_blocks), dim3(512), args, LDS_BYTES, stream);
    if (e != hipSuccess) fprintf(stderr, "cooperative launch failed: %s (grid %d)\n", hipGetErrorString(e), grid_blocks);
}
```
